# Optimizing an MI355X kernel written in HIP

```python
import math
import jax, jax.numpy as jnp
from jax import lax
import numpy as np

D_MODEL = 1024
BATCH = 2
SEQ = 8192
DEPTH = 1

CHUNK = 64
Q_BLOCK = 128
RET_HEADS = 4
RET_DK = 128
RET_DV = 256
RET_QK = RET_HEADS * RET_DK
RET_V = RET_HEADS * RET_DV
FOX_HEADS = 8
FOX_DH = 128
FOX_W = FOX_HEADS * FOX_DH
D_FF = (((8 * D_MODEL + 2) // 3 + 255) // 256) * 256
ROPE_THETA = 10000.0
EPS = 1e-6
SPLIT = (RET_QK, RET_QK, RET_V, RET_V, FOX_W, FOX_W, FOX_W, FOX_HEADS, D_MODEL, D_MODEL)
D_IN = 2 * RET_QK + 2 * RET_V + 3 * FOX_W + FOX_HEADS + 2 * D_MODEL

kernel_name = "hybrid_retention_fox_gated_block"


def rms_norm(x, w):
    xf = x.astype(jnp.float32)
    y = xf * lax.rsqrt(jnp.mean(xf * xf, axis=-1, keepdims=True) + EPS)
    return (y * w.astype(jnp.float32)).astype(x.dtype)


def modulate(h, shift, scale):
    return h * (1.0 + scale[:, None, :]) + shift[:, None, :]


def rotary(x, pos):
    half = x.shape[-1] // 2
    freqs = ROPE_THETA ** (-jnp.arange(half, dtype=jnp.float32) / half)
    ang = pos.astype(jnp.float32)[:, None] * freqs[None, :]
    cos = jnp.cos(ang)[None, :, None, :]
    sin = jnp.sin(ang)[None, :, None, :]
    xf = x.astype(jnp.float32)
    x1, x2 = xf[..., :half], xf[..., half:]
    return jnp.concatenate([x1 * cos - x2 * sin, x1 * sin + x2 * cos], axis=-1).astype(x.dtype)


def retention(q, k, v):
    B, S, H, dk = q.shape
    dv = v.shape[-1]
    N = S // CHUNK
    log_gamma = jnp.log(1.0 - jnp.exp2(-5.0 - jnp.arange(H, dtype=jnp.float32)))
    qc = q.astype(jnp.float32).reshape(B, N, CHUNK, H, dk)
    kc = k.astype(jnp.float32).reshape(B, N, CHUNK, H, dk)
    vc = v.astype(jnp.float32).reshape(B, N, CHUNK, H, dv)
    idx = jnp.arange(CHUNK, dtype=jnp.float32)
    d_intra = jnp.exp(log_gamma[:, None, None] * jnp.abs(idx[:, None] - idx[None, :]))
    scores = jnp.einsum('bnihd,bnjhd->bnhij', qc, kc) * d_intra
    intra = jnp.einsum('bnhij,bnjhe->bnihe', scores, vc)
    k_dec = jnp.exp(log_gamma[None, :] * (CHUNK - idx)[:, None])
    summ = jnp.einsum('bnjhd,bnjhe->bnhde', kc * k_dec[None, None, :, :, None], vc)
    chunk_decay = jnp.exp(log_gamma * CHUNK)[None, :, None, None]

    def step(state, a):
        return chunk_decay * state + a, state

    _, s_in = lax.scan(step, jnp.zeros((B, H, dk, dv), jnp.float32), jnp.moveaxis(summ, 1, 0))
    s_in = jnp.moveaxis(s_in, 0, 1)
    q_dec = jnp.exp(log_gamma[None, :] * idx[:, None])
    inter = jnp.einsum('bnihd,bnhde->bnihe', qc * q_dec[None, None, :, :, None], s_in)
    return (intra + inter).reshape(B, S, H, dv)


def forgetting_attention(q, k, v, log_f):
    B, S, H, d = q.shape
    nq = S // Q_BLOCK
    scale = 1.0 / math.sqrt(d)
    F = jnp.cumsum(log_f, axis=1).transpose(0, 2, 1)
    kt = k.transpose(0, 2, 1, 3)
    vt = v.transpose(0, 2, 1, 3)
    qb = jnp.moveaxis(q.transpose(0, 2, 1, 3).reshape(B, H, nq, Q_BLOCK, d), 2, 0)
    Fqb = jnp.moveaxis(F.reshape(B, H, nq, Q_BLOCK), 2, 0)
    kpos = jnp.arange(S)
    posb = kpos.reshape(nq, Q_BLOCK)

    def block(args):
        qi, fi, pi = args
        s = jnp.einsum('bhqd,bhkd->bhqk', qi, kt).astype(jnp.float32) * scale
        s = s + fi[..., :, None] - F[:, :, None, :]
        s = jnp.where((pi[:, None] >= kpos[None, :])[None, None], s, -jnp.inf)
        p = jax.nn.softmax(s, axis=-1)
        return jnp.einsum('bhqk,bhkd->bhqd', p.astype(vt.dtype), vt)

    out = lax.map(block, (qb, Fqb, posb))
    out = jnp.moveaxis(out, 0, 2).reshape(B, H, S, d).transpose(0, 2, 1, 3)
    return out.reshape(B, S, H * d)


def setup_inputs(seed: int = 0) -> dict:
    key = jax.random.key(seed)
    ks = jax.random.split(key, 16)
    f32 = jnp.float32
    L, D = DEPTH, D_MODEL
    nrm = lambda k, shape, fan: jax.random.normal(k, shape, f32) * (fan ** -0.5)
    return {
        "x": jax.random.normal(ks[0], (BATCH, SEQ, D), f32),
        "c": jax.random.normal(ks[1], (BATCH, D), f32),
        "ada_w": nrm(ks[2], (L, D, 6 * D), D) * 0.5,
        "ada_b": 0.01 * jax.random.normal(ks[3], (L, 6 * D), f32),
        "norm1_w": 1.0 + 0.01 * jax.random.normal(ks[4], (L, D), f32),
        "w_in": nrm(ks[5], (L, D, D_IN), D),
        "b_f": 1.0 + 3.0 * jax.random.uniform(ks[6], (L, FOX_HEADS), f32),
        "ret_proj": nrm(ks[7], (L, RET_V, D), RET_V),
        "fox_proj": nrm(ks[8], (L, FOX_W, D), FOX_W),
        "w_out": nrm(ks[9], (L, D, D), D),
        "norm2_w": 1.0 + 0.01 * jax.random.normal(ks[10], (L, D), f32),
        "w_gate": nrm(ks[11], (L, D, D_FF), D),
        "w_up": nrm(ks[12], (L, D, D_FF), D),
        "w_down": nrm(ks[13], (L, D_FF, D), D_FF),
        "norm_f_w": 1.0 + 0.01 * jax.random.normal(ks[14], (D,), f32),
    }


def reference(x, c, ada_w, ada_b, norm1_w, w_in, b_f, ret_proj, fox_proj, w_out,
              norm2_w, w_gate, w_up, w_down, norm_f_w):
    B, S, D = x.shape
    pos = jnp.arange(S)
    offs = [int(o) for o in np.cumsum(SPLIT)[:-1]]
    c_act = jax.nn.silu(c)
    for l in range(DEPTH):
        mod = c_act @ ada_w[l] + ada_b[l]
        sh1, sc1, g1, sh2, sc2, g2 = jnp.split(mod, 6, axis=-1)

        h = modulate(rms_norm(x, norm1_w[l]), sh1, sc1)
        z = h @ w_in[l]
        rq, rk, rv, rg, fq, fk, fv, ff, gr, gf = jnp.split(z, offs, axis=-1)

        rq = rotary(rq.reshape(B, S, RET_HEADS, RET_DK), pos)
        rk = rotary(rk.reshape(B, S, RET_HEADS, RET_DK), pos) * (RET_DK ** -0.5)
        ro = retention(rq, rk, rv.reshape(B, S, RET_HEADS, RET_DV))
        ro = ro * lax.rsqrt(jnp.mean(ro * ro, axis=-1, keepdims=True) + EPS)
        y_ret = (jax.nn.silu(rg.astype(jnp.float32)) * ro.reshape(B, S, RET_V)).astype(x.dtype)

        log_f = jax.nn.log_sigmoid((ff + b_f[l]).astype(jnp.float32))
        y_fox = forgetting_attention(fq.reshape(B, S, FOX_HEADS, FOX_DH),
                                     fk.reshape(B, S, FOX_HEADS, FOX_DH),
                                     fv.reshape(B, S, FOX_HEADS, FOX_DH), log_f)

        merged = jax.nn.sigmoid(gr) * (y_ret @ ret_proj[l]) + jax.nn.sigmoid(gf) * (y_fox @ fox_proj[l])
        x = x + g1[:, None, :] * (merged @ w_out[l])

        h2 = modulate(rms_norm(x, norm2_w[l]), sh2, sc2)
        ffn = (jax.nn.silu(h2 @ w_gate[l]) * (h2 @ w_up[l])) @ w_down[l]
        x = x + g2[:, None, :] * ffn
    return rms_norm(x, norm_f_w)
```

```cpp
#include <hip/hip_runtime.h>
#include <hip/hip_cooperative_groups.h>
#include <hip/hip_bf16.h>
#include <cstdio>
#include <cstdint>
namespace cg = cooperative_groups;

#define LAS __attribute__((address_space(3)))
typedef unsigned short bf16_t;
typedef short bf16x8 __attribute__((ext_vector_type(8)));
typedef short s16x4 __attribute__((ext_vector_type(4)));
typedef float f32x2 __attribute__((ext_vector_type(2)));
typedef float f32x4 __attribute__((ext_vector_type(4)));
typedef float f32x16 __attribute__((ext_vector_type(16)));
typedef unsigned u32x2 __attribute__((ext_vector_type(2)));
typedef unsigned u32x4 __attribute__((ext_vector_type(4)));
typedef __bf16 bf16x2_t __attribute__((ext_vector_type(2)));

constexpr int SEQ = 8192, DM = 1024, MTOK = 2 * SEQ, DFF = 2816, NGU = 2 * DFF, DINW = 8200, NIN = 8192;
constexpr float EPS = 1e-6f;
constexpr size_t MiB = 1u << 20;
constexpr size_t WS_MOD = 0;
constexpr size_t WS_BIAS2 = 64 * 1024;
constexpr size_t WS_LOGF = 128 * 1024;
constexpr size_t WS_G = 640 * 1024;
constexpr size_t WS_WIN = 2 * MiB;
constexpr size_t WS_PROJ = 18 * MiB;
constexpr size_t WS_WOUT = 22 * MiB;
constexpr size_t WS_WDOWN = 24 * MiB;
constexpr size_t WS_SSQ = 30 * MiB;
constexpr size_t WS_H = 32 * MiB;
constexpr size_t WS_RQK = 64 * MiB;
constexpr size_t WS_RV = 96 * MiB;
constexpr size_t WS_YB = 128 * MiB;
constexpr size_t WS_FK = 192 * MiB;
constexpr size_t WS_FV = 224 * MiB;
constexpr size_t WS_END = 256 * MiB;
constexpr int LDS_BYTES = 147456;

__device__ __forceinline__ unsigned cvtpk(float lo, float hi) { f32x2 v = {lo, hi}; bf16x2_t b = __builtin_convertvector(v, bf16x2_t); return __builtin_bit_cast(unsigned, b); }
__device__ __forceinline__ float bf2f(unsigned short b) { return __uint_as_float((unsigned)b << 16); }
__device__ __forceinline__ float bflo(unsigned w) { return __uint_as_float(w << 16); }
__device__ __forceinline__ float bfhi(unsigned w) { return __uint_as_float(w & 0xffff0000u); }
__device__ __forceinline__ float sigmoidf_(float x) { return 1.f / (1.f + __expf(-x)); }
__device__ __forceinline__ float siluf_(float x) { return x / (1.f + __expf(-x)); }
__device__ __forceinline__ float wave_sum(float v) {
#pragma unroll
    for (int o = 1; o < 64; o <<= 1) v += __shfl_xor(v, o);
    return v;
}
#define LDS_WAIT() asm volatile("s_waitcnt lgkmcnt(0)" ::: "memory")

namespace pg8 {
#define PG8_LAS __attribute__((address_space(3)))
constexpr int BM = 256, BK = 64, HALF = 128, HTB = HALF * BK * 2, STAGE_BYTES = 8 * HTB, NXCD = 8, WGM = 8;
__host__ __device__ __forceinline__ int lds_byte(int r, int c) { const int st = (r >> 4) * 2 + (c >> 5), rr = r & 15, cc = c & 31, ob = rr * 64 + cc * 2; return st * 1024 + (ob ^ (((ob >> 9) & 1) << 5)); }
__host__ __device__ __forceinline__ void stage_rc(int b, int& R, int& C) { const int st = b / 1024, sb = b % 1024, swz = sb ^ (((sb >> 9) & 1) << 5); R = (st >> 1) * 16 + swz / 64; C = (st & 1) * 32 + (swz % 64) / 2; }
__host__ __device__ __forceinline__ int perm32(int rho) { const int n = rho >> 4, i = rho & 15; return 8 * (i >> 2) + 4 * n + (i & 3); }
struct Unit { int pm, pn; };
struct Gemm { const bf16_t* A; const bf16_t* Bt; int M, N, K; };
struct StaticOrder {
    int nM, nN, nwg, G, c;
    __host__ __device__ void init(int M, int N, int G_, int c_) { nM = M / BM; nN = N / BM; nwg = nM * nN; G = G_; c = c_; }
    __host__ __device__ bool next(int i, Unit& u) const {
        const long L = (long)i * G + c; if (L >= nwg) return false;
        int wgid = (int)L; { const int q = nwg / NXCD, r = nwg % NXCD, xcd = wgid % NXCD, off = wgid / NXCD; wgid = (xcd < r ? xcd * (q + 1) : r * (q + 1) + (xcd - r) * q) + off; }
        const int nig = WGM * nN, gid = wgid / nig, fm = gid * WGM, gsz = (nM - fm) < WGM ? (nM - fm) : WGM;
        u.pm = fm + ((wgid % nig) % gsz); u.pn = (wgid % nig) / gsz; return true;
    }
};
template <class Epi, class Sched>
__device__ __forceinline__ void gemm_phase(PG8_LAS unsigned char* lds, const Gemm g, const Sched& S, const Epi& E) {
    int tid = threadIdx.x; asm volatile("" : "+v"(tid));
    const int wid = __builtin_amdgcn_readfirstlane(tid >> 6), lane = tid & 63, wr = wid >> 2, wc = wid & 3; int fr = lane & 15, fq = lane >> 4;
    const int K = g.K, nt = K / BK;
    unsigned voffA[2], voffB[2];
#pragma unroll
    for (int i = 0; i < 2; ++i) { int R, C; stage_rc(tid * 16 + i * 8192, R, C); const int Rb = (R & ~31) + perm32(R & 31);
        voffA[i] = (unsigned)(R * K + C) * 2u; voffB[i] = (unsigned)(Rb * K + C) * 2u; }
    const size_t kstep = (size_t)(BK * 2);
    const size_t hstep = (size_t)HALF * K * 2;
    const size_t tstep = 2 * hstep;
    const unsigned ldsw = (unsigned)wid * 1024u;
    const int aoff = lds_byte(wr * 64 + fr, fq * 8), boff = lds_byte(wc * 32 + fr, fq * 8);
#define PG8_SA(b, h) (((b) * 2 + (h)) * HTB)
#define PG8_SB(b, h) ((4 + (b) * 2 + (h)) * HTB)
#define PG8_STAGE(bufoff, gbase, voff) do { _Pragma("unroll") for (int _i = 0; _i < 2; ++_i) \
        __builtin_amdgcn_global_load_lds((const unsigned*)((const char*)(gbase) + (voff)[_i]), (PG8_LAS unsigned*)(lds + (bufoff) + ldsw + _i * 8192), 16, 0, 0); } while (0)
#define PG8_LDA(dst, b, h) do { _Pragma("unroll") for (int m = 0; m < 4; ++m) _Pragma("unroll") for (int k = 0; k < 2; ++k) dst[m][k] = *(const PG8_LAS bf16x8*)(lds + PG8_SA(b, h) + aoff + m * 2048 + k * 1024); } while (0)
#define PG8_LDB(dst, b, h) do { _Pragma("unroll") for (int n = 0; n < 2; ++n) _Pragma("unroll") for (int k = 0; k < 2; ++k) dst[n][k] = *(const PG8_LAS bf16x8*)(lds + PG8_SB(b, h) + boff + n * 2048 + k * 1024); } while (0)
#define PG8_MMA(ai, bj, At, Bt) do { __builtin_amdgcn_s_setprio(1); _Pragma("unroll") for (int m = 0; m < 4; ++m) _Pragma("unroll") for (int n = 0; n < 2; ++n) _Pragma("unroll") for (int k = 0; k < 2; ++k) \
        acc[ai][bj][m][n] = __builtin_amdgcn_mfma_f32_16x16x32_bf16(Bt[n][k], At[m][k], acc[ai][bj][m][n], 0, 0, 0); __builtin_amdgcn_s_setprio(0); } while (0)
#define PG8_WAIT_V(n) asm volatile("s_waitcnt vmcnt(" #n ")" ::: "memory")
#define PG8_WAIT_L(n) asm volatile("s_waitcnt lgkmcnt(" #n ")" ::: "memory")
#define PG8_BAR __builtin_amdgcn_s_barrier()
#define PG8_SCHED __builtin_amdgcn_sched_barrier(0)
    Unit cur, nxt; int ui = 0;
    if (!S.next(0, cur)) return;
    f32x4 acc[2][2][4][2];
#pragma unroll
    for (int a = 0; a < 2; ++a)
#pragma unroll
        for (int b = 0; b < 2; ++b)
#pragma unroll
            for (int m = 0; m < 4; ++m)
#pragma unroll
                for (int n = 0; n < 2; ++n) acc[a][b][m][n] = (f32x4){0.f, 0.f, 0.f, 0.f};
    bf16x8 At[4][2], B0[2][2], B1[2][2];
    const char* cA = (const char*)g.A + (size_t)cur.pm * tstep; const char* cB = (const char*)g.Bt + (size_t)cur.pn * tstep;
    PG8_STAGE(PG8_SB(0, 0), cB, voffB); PG8_STAGE(PG8_SB(0, 1), cB + hstep, voffB); PG8_STAGE(PG8_SA(0, 0), cA, voffA); PG8_STAGE(PG8_SA(0, 1), cA + hstep, voffA);
    if (wr == 1) PG8_BAR;
    PG8_WAIT_V(2); PG8_BAR;
    PG8_STAGE(PG8_SB(1, 0), cB + kstep, voffB); PG8_STAGE(PG8_SA(1, 0), cA + kstep, voffA); PG8_STAGE(PG8_SB(1, 1), cB + hstep + kstep, voffB);
    PG8_WAIT_V(6); PG8_BAR;
    for (;;) {
        const bool has_next = S.next(ui + 1, nxt);
        const char* nA = has_next ? (const char*)g.A + (size_t)nxt.pm * tstep : cA; const char* nB = has_next ? (const char*)g.Bt + (size_t)nxt.pn * tstep : cB;
        for (int t = 0; t < nt; t += 2) {
            const bool last = (t == nt - 2);
            const char* a1 = cA + (size_t)(t + 1) * kstep;
            const char* a2 = last ? nA : cA + (size_t)(t + 2) * kstep; const char* b2 = last ? nB : cB + (size_t)(t + 2) * kstep;
            const char* a3 = a2 + kstep; const char* b3 = b2 + kstep;
            if constexpr (Epi::MIDK) { if (t == nt / 2) E.mid(acc, cur, wr, wc, fr, fq); }
            PG8_LDB(B0, 0, 0); PG8_LDB(B1, 0, 1); PG8_SCHED; PG8_LDA(At, 0, 0); PG8_STAGE(PG8_SA(1, 1), a1 + hstep, voffA);
            PG8_WAIT_V(8); PG8_WAIT_L(0); PG8_BAR; PG8_MMA(0, 0, At, B0); PG8_MMA(0, 1, At, B1); PG8_BAR; PG8_SCHED;
            PG8_LDA(At, 0, 1); PG8_STAGE(PG8_SB(0, 0), b2, voffB); PG8_STAGE(PG8_SB(0, 1), b2 + hstep, voffB); PG8_STAGE(PG8_SA(0, 0), a2, voffA);
            PG8_WAIT_V(8); PG8_WAIT_L(0); PG8_BAR; PG8_MMA(1, 0, At, B0); PG8_MMA(1, 1, At, B1); PG8_BAR; PG8_SCHED;
            PG8_LDB(B0, 1, 0); PG8_LDB(B1, 1, 1); PG8_SCHED; PG8_LDA(At, 1, 0); PG8_STAGE(PG8_SA(0, 1), a2 + hstep, voffA);
            PG8_WAIT_V(8); PG8_WAIT_L(0); PG8_BAR; PG8_MMA(0, 0, At, B0); PG8_MMA(0, 1, At, B1); PG8_BAR; PG8_SCHED;
            PG8_LDA(At, 1, 1); PG8_STAGE(PG8_SB(1, 0), b3, voffB); PG8_STAGE(PG8_SB(1, 1), b3 + hstep, voffB); PG8_STAGE(PG8_SA(1, 0), a3, voffA);
            PG8_WAIT_V(8); PG8_WAIT_L(0); PG8_BAR; PG8_MMA(1, 0, At, B0); PG8_MMA(1, 1, At, B1); PG8_BAR; PG8_SCHED;
        }
        if (wr == 0) PG8_BAR;
        E(acc, cur, wr, wc, fr, fq);
        if (!has_next) break;
#pragma unroll
        for (int a = 0; a < 2; ++a)
#pragma unroll
            for (int b = 0; b < 2; ++b)
#pragma unroll
                for (int m = 0; m < 4; ++m)
#pragma unroll
                    for (int n = 0; n < 2; ++n) acc[a][b][m][n] = (f32x4){0.f, 0.f, 0.f, 0.f};
        cur = nxt; cA = nA; cB = nB; ++ui;
        if (wr == 1) PG8_BAR;
    }
    PG8_WAIT_V(0);
    PG8_BAR;
#undef PG8_SA
#undef PG8_SB
#undef PG8_STAGE
#undef PG8_LDA
#undef PG8_LDB
#undef PG8_MMA
#undef PG8_WAIT_V
#undef PG8_WAIT_L
#undef PG8_BAR
#undef PG8_SCHED
}
}

typedef const f32x4 (&AccRef)[2][2][4][2];
typedef f32x4 (&AccMut)[2][2][4][2];
__device__ __forceinline__ u32x4 pack8(f32x4 a, f32x4 b) { u32x4 w; w.x = cvtpk(a[0], a[1]); w.y = cvtpk(a[2], a[3]); w.z = cvtpk(b[0], b[1]); w.w = cvtpk(b[2], b[3]); return w; }

struct EpiIn {
    static constexpr bool MIDK = false;
    bf16_t *RQK, *RV, *YB, *FK, *FV, *GRF;
    __device__ __forceinline__ void mid(AccMut, const pg8::Unit&, int, int, int, int) const {}
    __device__ __forceinline__ void operator()(AccRef acc, const pg8::Unit& u, int wr, int wc, int fr, int fq) const {
        const int pn = u.pn; int mode = 0, pitch = 1024, coff; bf16_t* base;
        if (pn < 4) { mode = pn < 2 ? 1 : 2; base = RQK; coff = pn * 256; }
        else if (pn < 8) { base = RV; coff = (pn - 4) * 256; }
        else if (pn < 12) { mode = 3; base = YB; pitch = 2048; coff = (pn - 8) * 256; }
        else if (pn < 16) { base = YB; pitch = 2048; coff = 1024 + (pn - 12) * 256; }
        else if (pn < 20) { base = FK; coff = (pn - 16) * 256; }
        else if (pn < 24) { base = FV; coff = (pn - 20) * 256; }
        else { mode = 4; base = GRF; pitch = 2048; coff = (pn - 24) * 256; }
        asm volatile("" : "+v"(fr), "+v"(fq));
        const int row0 = u.pm * 256 + wr * 64 + fr, col0 = coff + wc * 32 + 8 * fq;
        if (mode == 1 || mode == 2) {
            float fr4[4];
#pragma unroll
            for (int p = 0; p < 4; ++p) fr4[p] = powf(10000.0f, -(float)(16 * wc + 4 * fq + p) * (1.0f / 64.0f));
            const float ks = mode == 2 ? 0.08838834764831845f : 1.0f;
#pragma unroll
            for (int ai = 0; ai < 2; ++ai)
#pragma unroll
                for (int m = 0; m < 4; ++m) {
                    const int row = row0 + ai * 128 + m * 16; const float pos = (float)(row & (SEQ - 1));
                    float cs[4], sn[4];
#pragma unroll
                    for (int p = 0; p < 4; ++p) { const float ang = pos * fr4[p]; double t = (double)ang * 0.15915494309189535; t -= floor(t); const float tf = (float)t;
                        sn[p] = __builtin_amdgcn_sinf(tf) * ks; cs[p] = __builtin_amdgcn_cosf(tf) * ks; }
#pragma unroll
                    for (int bj = 0; bj < 2; ++bj) { const f32x4 v0 = acc[ai][bj][m][0], v1 = acc[ai][bj][m][1]; f32x4 o0, o1;
                        o0[0] = v0[0] * cs[0] - v0[1] * sn[0]; o0[1] = v0[0] * sn[0] + v0[1] * cs[0];
                        o0[2] = v0[2] * cs[1] - v0[3] * sn[1]; o0[3] = v0[2] * sn[1] + v0[3] * cs[1];
                        o1[0] = v1[0] * cs[2] - v1[1] * sn[2]; o1[1] = v1[0] * sn[2] + v1[1] * cs[2];
                        o1[2] = v1[2] * cs[3] - v1[3] * sn[3]; o1[3] = v1[2] * sn[3] + v1[3] * cs[3];
                        *(u32x4*)(base + (size_t)row * pitch + col0 + bj * 128) = pack8(o0, o1); }
                }
        } else {
#pragma unroll
            for (int ai = 0; ai < 2; ++ai)
#pragma unroll
                for (int m = 0; m < 4; ++m) {
                    const int row = row0 + ai * 128 + m * 16;
#pragma unroll
                    for (int bj = 0; bj < 2; ++bj) { f32x4 v0 = acc[ai][bj][m][0], v1 = acc[ai][bj][m][1];
                        if (mode == 3) {
#pragma unroll
                            for (int q = 0; q < 4; ++q) { v0[q] = siluf_(v0[q]); v1[q] = siluf_(v1[q]); } }
                        else if (mode == 4) {
#pragma unroll
                            for (int q = 0; q < 4; ++q) { v0[q] = sigmoidf_(v0[q]); v1[q] = sigmoidf_(v1[q]); } }
                        *(u32x4*)(base + (size_t)row * pitch + col0 + bj * 128) = pack8(v0, v1); }
                }
        }
    }
};
struct EpiMerge {
    static constexpr bool MIDK = true;
    const bf16_t* GRF; bf16_t* OUT;
    __device__ __forceinline__ void mid(AccMut acc, const pg8::Unit& u, int wr, int wc, int fr, int fq) const {
        asm volatile("" : "+v"(fr), "+v"(fq));
        const int row0 = u.pm * 256 + wr * 64 + fr, col0 = u.pn * 256 + wc * 32 + 8 * fq;
#pragma unroll
        for (int ai = 0; ai < 2; ++ai)
#pragma unroll
            for (int m = 0; m < 4; ++m) { const int row = row0 + ai * 128 + m * 16;
#pragma unroll
                for (int bj = 0; bj < 2; ++bj) { const u32x4 gr = *(const u32x4*)(GRF + (size_t)row * 2048 + col0 + bj * 128), gf = *(const u32x4*)(GRF + (size_t)row * 2048 + 1024 + col0 + bj * 128);
                    f32x4 r0, r1;
                    r0[0] = bflo(gr.x) / bflo(gf.x); r0[1] = bfhi(gr.x) / bfhi(gf.x); r0[2] = bflo(gr.y) / bflo(gf.y); r0[3] = bfhi(gr.y) / bfhi(gf.y);
                    r1[0] = bflo(gr.z) / bflo(gf.z); r1[1] = bfhi(gr.z) / bfhi(gf.z); r1[2] = bflo(gr.w) / bflo(gf.w); r1[3] = bfhi(gr.w) / bfhi(gf.w);
                    acc[ai][bj][m][0] *= r0; acc[ai][bj][m][1] *= r1; }
                __builtin_amdgcn_sched_barrier(0); }
    }
    __device__ __forceinline__ void operator()(AccRef acc, const pg8::Unit& u, int wr, int wc, int fr, int fq) const {
        asm volatile("" : "+v"(fr), "+v"(fq));
        const int row0 = u.pm * 256 + wr * 64 + fr, col0 = u.pn * 256 + wc * 32 + 8 * fq;
#pragma unroll
        for (int ai = 0; ai < 2; ++ai)
#pragma unroll
            for (int m = 0; m < 4; ++m) { const int row = row0 + ai * 128 + m * 16;
#pragma unroll
                for (int bj = 0; bj < 2; ++bj) { const u32x4 gf = *(const u32x4*)(GRF + (size_t)row * 2048 + 1024 + col0 + bj * 128);
                    f32x4 r0, r1; r0[0] = bflo(gf.x); r0[1] = bfhi(gf.x); r0[2] = bflo(gf.y); r0[3] = bfhi(gf.y); r1[0] = bflo(gf.z); r1[1] = bfhi(gf.z); r1[2] = bflo(gf.w); r1[3] = bfhi(gf.w);
                    *(u32x4*)(OUT + (size_t)row * 1024 + col0 + bj * 128) = pack8(acc[ai][bj][m][0] * r0, acc[ai][bj][m][1] * r1); } }
    }
};
struct EpiWout {
    static constexpr bool MIDK = false;
    const float* X; const float* MOD; const float* N2W; float* X1; bf16_t* A2; float* SSQ;
    __device__ __forceinline__ void mid(AccMut, const pg8::Unit&, int, int, int, int) const {}
    __device__ __forceinline__ void operator()(AccRef acc, const pg8::Unit& u, int wr, int wc, int fr, int fq) const {
        asm volatile("" : "+v"(fr), "+v"(fq));
        const int row0 = u.pm * 256 + wr * 64 + fr, col0 = u.pn * 256 + wc * 32 + 8 * fq; const int b = u.pm >> 5;
        const float* mod = MOD + b * 6144;
        f32x4 g1[2][2], w2[2][2];
#pragma unroll
        for (int bj = 0; bj < 2; ++bj)
#pragma unroll
            for (int n = 0; n < 2; ++n) { const int c = col0 + bj * 128 + 4 * n; g1[bj][n] = *(const f32x4*)(mod + 2048 + c);
                const f32x4 sc = *(const f32x4*)(mod + 4096 + c), nw = *(const f32x4*)(N2W + c); w2[bj][n] = nw * (sc + 1.0f); }
#pragma unroll
        for (int ai = 0; ai < 2; ++ai)
#pragma unroll
            for (int m = 0; m < 4; ++m) { const int row = row0 + ai * 128 + m * 16; float ss = 0.f;
#pragma unroll
                for (int bj = 0; bj < 2; ++bj) { const size_t off = (size_t)row * 1024 + col0 + bj * 128;
                    const f32x4 x0 = *(const f32x4*)(X + off), x1v = *(const f32x4*)(X + off + 4);
                    const f32x4 y0 = x0 + g1[bj][0] * acc[ai][bj][m][0], y1 = x1v + g1[bj][1] * acc[ai][bj][m][1];
                    *(f32x4*)(X1 + off) = y0; *(f32x4*)(X1 + off + 4) = y1;
                    ss += (y0[0] * y0[0] + y0[1] * y0[1]) + (y0[2] * y0[2] + y0[3] * y0[3]) + (y1[0] * y1[0] + y1[1] * y1[1]) + (y1[2] * y1[2] + y1[3] * y1[3]);
                    *(u32x4*)(A2 + off) = pack8(y0 * w2[bj][0], y1 * w2[bj][1]); }
                ss += __shfl_xor(ss, 16); ss += __shfl_xor(ss, 32);
                if (fq == 0) SSQ[(size_t)row * 16 + u.pn * 4 + wc] = ss; }
    }
};
struct EpiGU {
    static constexpr bool MIDK = false;
    const float* SSQ; const float* BIAS2; bf16_t* ACT;
    __device__ __forceinline__ void mid(AccMut, const pg8::Unit&, int, int, int, int) const {}
    __device__ __forceinline__ void operator()(AccRef acc, const pg8::Unit& u, int wr, int wc, int fr, int fq) const {
        asm volatile("" : "+v"(fr), "+v"(fq));
        const int row0 = u.pm * 256 + wr * 64 + fr, col0 = u.pn * 256 + wc * 32 + 8 * fq; const int b = u.pm >> 5;
        const float* bias = BIAS2 + b * NGU;
        f32x4 bv[2][2];
#pragma unroll
        for (int bj = 0; bj < 2; ++bj)
#pragma unroll
            for (int n = 0; n < 2; ++n) bv[bj][n] = *(const f32x4*)(bias + col0 + bj * 128 + 4 * n);
#pragma unroll
        for (int ai = 0; ai < 2; ++ai)
#pragma unroll
            for (int m = 0; m < 4; ++m) { const int row = row0 + ai * 128 + m * 16;
                const f32x4* sp = (const f32x4*)(SSQ + (size_t)row * 16); const f32x4 s0 = sp[0], s1 = sp[1], s2 = sp[2], s3 = sp[3];
                const float tot = ((s0[0] + s0[1]) + (s0[2] + s0[3])) + ((s1[0] + s1[1]) + (s1[2] + s1[3])) + ((s2[0] + s2[1]) + (s2[2] + s2[3])) + ((s3[0] + s3[1]) + (s3[2] + s3[3]));
                const float rstd = 1.0f / sqrtf(tot * (1.0f / 1024.0f) + EPS);
#pragma unroll
                for (int bj = 0; bj < 2; ++bj) { const f32x4 v0 = acc[ai][bj][m][0] * rstd + bv[bj][0], v1 = acc[ai][bj][m][1] * rstd + bv[bj][1];
                    u32x2 w; w.x = cvtpk(siluf_(v0[0]) * v0[1], siluf_(v0[2]) * v0[3]); w.y = cvtpk(siluf_(v1[0]) * v1[1], siluf_(v1[2]) * v1[3]);
                    *(u32x2*)(ACT + (size_t)row * DFF + ((col0 + bj * 128) >> 1)) = w; } }
    }
};
struct EpiDown {
    static constexpr bool MIDK = false;
    const float* MOD; float* X1;
    __device__ __forceinline__ void mid(AccMut, const pg8::Unit&, int, int, int, int) const {}
    __device__ __forceinline__ void operator()(AccRef acc, const pg8::Unit& u, int wr, int wc, int fr, int fq) const {
        asm volatile("" : "+v"(fr), "+v"(fq));
        const int row0 = u.pm * 256 + wr * 64 + fr, col0 = u.pn * 256 + wc * 32 + 8 * fq; const int b = u.pm >> 5;
        const float* mod = MOD + b * 6144 + 5120;
        f32x4 g2[2][2];
#pragma unroll
        for (int bj = 0; bj < 2; ++bj)
#pragma unroll
            for (int n = 0; n < 2; ++n) g2[bj][n] = *(const f32x4*)(mod + col0 + bj * 128 + 4 * n);
#pragma unroll
        for (int ai = 0; ai < 2; ++ai)
#pragma unroll
            for (int m = 0; m < 4; ++m) { const int row = row0 + ai * 128 + m * 16;
#pragma unroll
                for (int bj = 0; bj < 2; ++bj) { const size_t off = (size_t)row * 1024 + col0 + bj * 128;
                    const f32x4 x0 = *(const f32x4*)(X1 + off), x1v = *(const f32x4*)(X1 + off + 4);
                    *(f32x4*)(X1 + off) = x0 + g2[bj][0] * acc[ai][bj][m][0]; *(f32x4*)(X1 + off + 4) = x1v + g2[bj][1] * acc[ai][bj][m][1]; } }
    }
};

namespace fox {
constexpr int D = 128, QP = 2048, KVP = 1024;
constexpr float SCALE = 0.08838834764831845f, THR = 8.f;
constexpr int NW = 8, QBLK = 32, KVBLK = 64, QB = NW * QBLK;
constexpr int SHM_V = KVBLK * D * 2, SHM_K = KVBLK * D * 2;
constexpr int LDS_G = 2 * SHM_V + 2 * SHM_K + NW * 64 * 4;
constexpr int LDS_BYTES = LDS_G + 2 * 64 * 4;
#define KSWZ(row, colB) ((row) * 256 + ((colB) ^ (((row) & 7) << 4)))
#define SBAR() __builtin_amdgcn_sched_barrier(0)
__device__ __forceinline__ int v_st(int k, int c) { const int kk = (k & ~0xC) | ((k & 4) << 1) | ((k & 8) >> 1); return ((kk >> 3) * 4 + (c >> 5)) * 512 + ((kk & 7) * 32 + (c & 31)) * 2; }
__device__ __forceinline__ int v_rd_base(int lane) { return ((lane & 3) << 3) | (((lane >> 2) & 3) << 6) | (((lane >> 4) & 1) << 5) | (((lane >> 5) & 1) << 8); }
constexpr int v_rd_off(int d0, int ks, int half) { return d0 * 512 + ks * 4096 + half * 2048; }
__device__ __forceinline__ int crow(int r, int hi) { return (r & 3) + 8 * (r >> 2) + 4 * hi; }
__device__ __forceinline__ unsigned cvtpk_a(float lo, float hi) { unsigned r; asm volatile("v_cvt_pk_bf16_f32 %0, %1, %2" : "=v"(r) : "v"(lo), "v"(hi)); return r; }
__device__ __forceinline__ bf16x8 load8(const bf16_t* p) { return *reinterpret_cast<const bf16x8*>(p); }
__device__ __forceinline__ bf16x8 ldu(const void* ubase, unsigned off) { return *reinterpret_cast<const bf16x8*>((const char*)ubase + off); }
__device__ __forceinline__ void mask_tile(f32x16& p0, f32x16& p1, int dq) {
    const float NEG = -__builtin_inff();
#pragma unroll
    for (int r = 0; r < 16; ++r) { const int c = (r & 3) + 8 * (r >> 2); if (dq - c < 0) p0[r] = NEG; if (dq - c - 32 < 0) p1[r] = NEG; }
}
__device__ __forceinline__ void partialSM(f32x16& p0, f32x16& p1, float& m_reg, float& mn, float& alpha) {
    float pmax = p0[0];
#pragma unroll
    for (int r = 1; r < 16; ++r) pmax = fmaxf(pmax, p0[r]);
#pragma unroll
    for (int r = 0; r < 16; ++r) pmax = fmaxf(pmax, p1[r]);
    { auto rr = __builtin_amdgcn_permlane32_swap(__float_as_uint(pmax), __float_as_uint(pmax), false, false);
      pmax = fmaxf(__uint_as_float(rr[0]), __uint_as_float(rr[1])); }
    constexpr float C2 = 1.4426950408889634f * SCALE;
    if (__builtin_expect(__all((pmax - m_reg) * SCALE <= THR), 1)) { mn = m_reg; alpha = 1.f; }
    else { mn = fmaxf(m_reg, pmax); alpha = __builtin_amdgcn_exp2f((m_reg - mn) * C2); m_reg = mn; }
    const float mnL = -mn * C2;
#pragma unroll
    for (int r = 0; r < 16; ++r) p0[r] = fmaf(p0[r], C2, mnL);
#pragma unroll
    for (int r = 0; r < 16; ++r) p1[r] = fmaf(p1[r], C2, mnL);
#pragma unroll
    for (int r = 0; r < 16; ++r) p0[r] = __builtin_amdgcn_exp2f(p0[r]);
}
__device__ __forceinline__ void finishSM(f32x16& p0, f32x16& p1, float alpha, float& l_reg, bf16x8& pa0, bf16x8& pa1, bf16x8& pa2, bf16x8& pa3) {
#pragma unroll
    for (int r = 0; r < 16; ++r) p1[r] = __builtin_amdgcn_exp2f(p1[r]);
    float ps = 0;
#pragma unroll
    for (int r = 0; r < 16; ++r) ps += p0[r];
#pragma unroll
    for (int r = 0; r < 16; ++r) ps += p1[r];
    { auto rr = __builtin_amdgcn_permlane32_swap(__float_as_uint(ps), __float_as_uint(ps), false, false);
      ps = __uint_as_float(rr[0]) + __uint_as_float(rr[1]); }
    l_reg = l_reg * alpha + ps;
#define PK4(P, B_, OUT) do { unsigned a0 = cvtpk_a(P[B_+0], P[B_+1]), a1 = cvtpk_a(P[B_+2], P[B_+3]);                          \
        unsigned b0 = cvtpk_a(P[B_+4], P[B_+5]), b1 = cvtpk_a(P[B_+6], P[B_+7]);                                             \
        auto r0 = __builtin_amdgcn_permlane32_swap(a0, b0, false, false); auto r1 = __builtin_amdgcn_permlane32_swap(a1, b1, false, false); \
        u32x4 w = {r0[0], r1[0], r0[1], r1[1]}; OUT = *reinterpret_cast<bf16x8*>(&w); } while (0)
    PK4(p0, 0, pa0); PK4(p0, 8, pa1); PK4(p1, 0, pa2); PK4(p1, 8, pa3);
#undef PK4
}
template <int KB>
__device__ __forceinline__ void qkt(f32x16& p0, f32x16& p1, const char* K_lds, const char* G_lds, int r32, int hi, const bf16x8* qr) {
    const f32x4* gl = (const f32x4*)(G_lds + KB * 256 + hi * 16);
#pragma unroll
    for (int j = 0; j < 4; ++j) { const f32x4 a = gl[2 * j], b = gl[8 + 2 * j];
#pragma unroll
        for (int i = 0; i < 4; ++i) { p0[4 * j + i] = a[i]; p1[4 * j + i] = b[i]; } }
    const char* kb[4];
#pragma unroll
    for (int dd = 0; dd < 4; ++dd) kb[dd] = K_lds + KB * SHM_K + KSWZ(r32, (dd * 16 + hi * 8) * 2);
#pragma unroll
    for (int d0 = 0; d0 < 8; ++d0) { const char* a = kb[d0 & 3] + (d0 >> 2) * 128;
        bf16x8 b0 = *reinterpret_cast<const bf16x8*>(a);
        bf16x8 b1 = *reinterpret_cast<const bf16x8*>(a + 32 * 256);
        p0 = __builtin_amdgcn_mfma_f32_32x32x16_bf16(b0, qr[d0], p0, 0, 0, 0);
        p1 = __builtin_amdgcn_mfma_f32_32x32x16_bf16(b1, qr[d0], p1, 0, 0, 0); }
}
template <int VB>
__device__ __forceinline__ void pv_tile(f32x16* o, int vb0, bf16x8 pa0, bf16x8 pa1, bf16x8 pa2, bf16x8 pa3) {
#define TRRD(dst, off) asm volatile("ds_read_b64_tr_b16 %0, %1 offset:%2" : "=&v"(dst) : "v"(vb0), "i"(off) : "memory")
#define PV_D0(d0) do { s16x4 l0, l1, l2, l3, h0, h1, h2, h3; constexpr int b_ = VB * SHM_V + v_rd_off(d0, 0, 0); \
        TRRD(l0, b_); TRRD(h0, b_ + 2048); TRRD(l1, b_ + 4096); TRRD(h1, b_ + 6144); TRRD(l2, b_ + 8192); TRRD(h2, b_ + 10240); TRRD(l3, b_ + 12288); TRRD(h3, b_ + 14336); \
        asm volatile("s_waitcnt lgkmcnt(0)" ::: "memory"); SBAR();   \
        o[d0] = __builtin_amdgcn_mfma_f32_32x32x16_bf16(pa0, (bf16x8){l0[0], l0[1], l0[2], l0[3], h0[0], h0[1], h0[2], h0[3]}, o[d0], 0, 0, 0);   \
        o[d0] = __builtin_amdgcn_mfma_f32_32x32x16_bf16(pa1, (bf16x8){l1[0], l1[1], l1[2], l1[3], h1[0], h1[1], h1[2], h1[3]}, o[d0], 0, 0, 0);   \
        o[d0] = __builtin_amdgcn_mfma_f32_32x32x16_bf16(pa2, (bf16x8){l2[0], l2[1], l2[2], l2[3], h2[0], h2[1], h2[2], h2[3]}, o[d0], 0, 0, 0);   \
        o[d0] = __builtin_amdgcn_mfma_f32_32x32x16_bf16(pa3, (bf16x8){l3[0], l3[1], l3[2], l3[3], h3[0], h3[1], h3[2], h3[3]}, o[d0], 0, 0, 0); } while (0)
    PV_D0(0); PV_D0(1); PV_D0(2); PV_D0(3);
#undef PV_D0
#undef TRRD
}
struct BlockRef { const bf16_t* Q; const bf16_t* K; const bf16_t* V; bf16_t* O; const float* G; int P0; };
struct Seam { bf16x8 qr[8]; bf16x8 st_v0, st_v1, st_k0, st_k1; float g0, g1; };
#define ROW(p, k0, rr) ((p) + (size_t)((k0) + (rr)) * KVP + sc)
#define VMW() asm volatile("s_waitcnt vmcnt(0)" ::: "memory")
#define VMWN(n) asm volatile("s_waitcnt vmcnt(%0)" :: "i"(n) : "memory")
#define SLOAD_H(Kp, Vp, Gp, gqv, k0) do { const bf16_t* kt_ = (Kp) + (size_t)(k0) * KVP; const bf16_t* vt_ = (Vp) + (size_t)(k0) * KVP; const float* gt_ = (Gp) + (k0); \
                         S.st_v0 = ldu(vt_, loff); S.st_v1 = ldu(vt_ + 32 * KVP, loff); S.st_k0 = ldu(kt_, loff); S.st_k1 = ldu(kt_ + 32 * KVP, loff); \
                         S.g0 = (gqv) - *(const float*)((const char*)gt_ + goff); S.g1 = (gqv) - *(const float*)((const char*)(gt_ + 32) + goff); } while (0)
#define SWRITE_HK(bf) do { *(bf16x8*)(K_lds + (bf) * SHM_K + kws) = S.st_k0; *(bf16x8*)(K_lds + (bf) * SHM_K + kws + 32 * 256) = S.st_k1; \
                           if ((tid & 15) == 0) { ((float*)(G_lds + (bf) * 256))[sr] = S.g0; ((float*)(G_lds + (bf) * 256))[32 + sr] = S.g1; } } while (0)
#define SWRITE_HV(bf) do { *(bf16x8*)(V_lds + (bf) * SHM_V + vst0) = S.st_v0; *(bf16x8*)(V_lds + (bf) * SHM_V + vst1) = S.st_v1; } while (0)
#define SWRITE_H(bf) do { SWRITE_HV(bf); SWRITE_HK(bf); } while (0)
__device__ __forceinline__ void prime(const BlockRef& cur, char* lds, Seam& S) {
    int tid = threadIdx.x; asm volatile("" : "+v"(tid)); const int wid = __builtin_amdgcn_readfirstlane(tid >> 6), lane = tid & 63, r32 = lane & 31, hi = lane >> 5;
    const int sr = tid >> 4, sc = (tid & 15) * 8, kws = KSWZ(sr, sc * 2); char* K_lds = lds + 2 * SHM_V; char* G_lds = lds + LDS_G;
    const unsigned loff = (unsigned)(sr * KVP + sc) * 2u, goff = (unsigned)sr * 4u, qoff = (unsigned)(r32 * QP + hi * 8) * 2u;
    { const bf16_t* qb_ = cur.Q + (size_t)(wid * QBLK) * QP;
#pragma unroll
    for (int d0 = 0; d0 < 8; ++d0) S.qr[d0] = ldu(qb_ + d0 * 16, qoff); }
    SLOAD_H(cur.K, cur.V, cur.G, cur.G[cur.P0], 0); VMW(); SWRITE_HK(0);
    __syncthreads();
}
__device__ __forceinline__ void block(const BlockRef& cur, const BlockRef& nxt, char* lds, Seam& S) {
    int tid = threadIdx.x; asm volatile("" : "+v"(tid)); const int wid = __builtin_amdgcn_readfirstlane(tid >> 6), lane = tid & 63, r32 = lane & 31, hi = lane >> 5;
    const int NT = (cur.P0 + QB) / KVBLK;
    const int qlo = cur.P0 + wid * QBLK, qm = qlo + r32 - 4 * hi;
    char* V_lds = lds; char* K_lds = lds + 2 * SHM_V; char* G_lds = lds + LDS_G;
    float* ws = (float*)(lds + 2 * SHM_V + 2 * SHM_K) + wid * 64; float* li_l = ws, * al_l = ws + 32;
    float m_reg = -1e30f, l_reg = 0; f32x16 o[4] = {};
    const int sr = tid >> 4, sc = (tid & 15) * 8, vst0 = v_st(sr, sc), vst1 = v_st(32 + sr, sc), kws = KSWZ(sr, sc * 2);
    const unsigned loff = (unsigned)(sr * KVP + sc) * 2u, goff = (unsigned)sr * 4u, qoff = (unsigned)(r32 * QP + hi * 8) * 2u;
    const int vb0 = (int)(uintptr_t)V_lds + v_rd_base(lane);
    const bf16_t* Kh = cur.K; const bf16_t* Vh = cur.V; const float* Gh = cur.G;
    const float gq = Gh[cur.P0];
#define RESC(a) do { if (__any((a) < 1.f)) { if (hi == 0) al_l[r32] = (a); asm volatile("s_waitcnt lgkmcnt(0)" ::: "memory");              \
                     for (int d_ = 0; d_ < 4; ++d_) for (int r = 0; r < 16; ++r) o[d_][r] *= al_l[crow(r, hi)]; } } while (0)
#define KBASE(t) ((t) * KVBLK)
#define MASKT(P0_, P1_, t) do { const int kb_ = KBASE(t); if (kb_ + KVBLK - 1 > qlo) mask_tile(P0_, P1_, qm - kb_); } while (0)
    constexpr int NQL = 8;
#define SEAM_K0() do { VMWN(NQL); SWRITE_HK(0); SBAR(); } while (0)
    f32x16 pA0, pA1, pB0, pB1; float mnA, mnB, alA, alB; bf16x8 pa0, pa1, pa2, pa3;
    SWRITE_HV(0); SBAR();
    if (NT > 1) { SLOAD_H(Kh, Vh, Gh, gq, KBASE(1)); }
    SBAR(); qkt<0>(pA0, pA1, K_lds, G_lds, r32, hi, S.qr);
    MASKT(pA0, pA1, 0); partialSM(pA0, pA1, m_reg, mnA, alA);
    if (NT > 1) { VMW(); SWRITE_H(1); }
    __syncthreads();
#define HALF_STEP(PX0, PX1, mnX, alX, PY0, PY1, alY, t, KB, VB, SB) do {                                                      \
        SBAR(); qkt<KB>(PX0, PX1, K_lds, G_lds, r32, hi, S.qr);                                             \
        finishSM(PY0, PY1, alY, l_reg, pa0, pa1, pa2, pa3); SBAR();                                                           \
        if ((t) + 1 < NT) { SLOAD_H(Kh, Vh, Gh, gq, KBASE((t) + 1)); SBAR(); }                                               \
        pv_tile<VB>(o, vb0, pa0, pa1, pa2, pa3); MASKT(PX0, PX1, (t)); partialSM(PX0, PX1, m_reg, mnX, alX);                                        \
        __syncthreads();                                                                                                      \
        if ((t) + 1 < NT) { VMW(); SWRITE_H(SB); }                                                                          \
        RESC(alX); __syncthreads(); } while (0)
    for (int t = 1; t + 1 < NT; t += 2) {
        HALF_STEP(pB0, pB1, mnB, alB, pA0, pA1, alA, t, 1, 0, 0);
        HALF_STEP(pA0, pA1, mnA, alA, pB0, pB1, alB, t + 1, 0, 1, 1);
    }
    { SBAR(); qkt<1>(pB0, pB1, K_lds, G_lds, r32, hi, S.qr); SBAR(); }
    SLOAD_H(nxt.K, nxt.V, nxt.G, nxt.G[nxt.P0], 0); SBAR();
    { const bf16_t* qb_ = nxt.Q + (size_t)(wid * QBLK) * QP;
#pragma unroll
    for (int d0 = 0; d0 < 8; ++d0) S.qr[d0] = ldu(qb_ + d0 * 16, qoff); }
    SBAR();
    finishSM(pA0, pA1, alA, l_reg, pa0, pa1, pa2, pa3); SBAR();
    pv_tile<0>(o, vb0, pa0, pa1, pa2, pa3);
    { MASKT(pB0, pB1, NT - 1); partialSM(pB0, pB1, m_reg, mnB, alB); __syncthreads(); RESC(alB);
      finishSM(pB0, pB1, alB, l_reg, pa0, pa1, pa2, pa3); SBAR(); pv_tile<1>(o, vb0, pa0, pa1, pa2, pa3); }
    SBAR(); SEAM_K0();
    if (hi == 0) li_l[r32] = l_reg; asm volatile("s_waitcnt lgkmcnt(0)" ::: "memory");
    float rli[16];
#pragma unroll
    for (int r = 0; r < 16; ++r) rli[r] = __builtin_amdgcn_rcpf(li_l[crow(r, hi)]);
    bf16_t* Ow = cur.O + (size_t)(wid * QBLK) * QP;
    unsigned ooff = (unsigned)(4 * hi * QP + r32) * 2u; asm volatile("" : "+v"(ooff));
#pragma unroll
    for (int r = 0; r < 16; ++r) { char* orp = (char*)(Ow + (size_t)((r & 3) + 8 * (r >> 2)) * QP);
#pragma unroll
        for (int d0 = 0; d0 < 4; ++d0) { const float v = o[d0][r] * rli[r];
            const float vn = __shfl_xor(v, 1);
            if ((r32 & 1) == 0) *(unsigned*)(orp + ooff + d0 * 64) = cvtpk_a(v, vn); } }
    __syncthreads();
#undef RESC
#undef KBASE
#undef MASKT
#undef SEAM_K0
#undef HALF_STEP
}
#undef ROW
#undef VMW
#undef VMWN
#undef SLOAD_H
#undef SWRITE_HK
#undef SWRITE_HV
#undef SWRITE_H
#undef KSWZ
#undef SBAR
}

namespace ret {
constexpr int PQ = 272, PT = 144, PO = 528;
constexpr int L_Q = 0, L_K = 64 * PQ, L_KT = L_K + 64 * PQ, L_VT = L_KT + 128 * PT, L_P = L_VT + 256 * PT, L_O = L_P + 64 * PT, L_END = L_O + 64 * PO;
static_assert(L_END <= 140000, "retention LDS");
__device__ __forceinline__ int crow(int r, int hi) { return (r & 3) + 8 * (r >> 2) + 4 * hi; }
#define MF32(a, b, c) __builtin_amdgcn_mfma_f32_32x32x16_bf16((a), (b), (c), 0, 0, 0)
__device__ __forceinline__ bf16x8 ld16(const LAS unsigned char* p) { return *(const LAS bf16x8*)p; }
template <bool PH2>
__device__ __forceinline__ void unit(int bh, int g, const bf16_t* RQK, const bf16_t* RV, bf16_t* YB, float* GS, LAS unsigned char* lds) {
    int tid = threadIdx.x; asm volatile("" : "+v"(tid)); const int w = __builtin_amdgcn_readfirstlane(tid >> 6), lane = tid & 63, r32 = lane & 31, hi = lane >> 5;
    const int b = bh >> 2, h = bh & 3;
    const float lg = log2f(1.0f - exp2f(-5.0f - (float)h));
    const float dchunk = exp2f(64.f * lg);
    f32x16 st[4];
#pragma unroll
    for (int db = 0; db < 4; ++db) st[db] = f32x16{};
    if (PH2) {
        const float dgrp = exp2f(512.f * lg);
        for (int gp = 0; gp < g; ++gp) { const float* src = GS + ((size_t)(bh * 16 + gp) * 128) * 256 + 32 * w + r32;
#pragma unroll
            for (int db = 0; db < 4; ++db)
#pragma unroll
                for (int r = 0; r < 16; ++r) st[db][r] = st[db][r] * dgrp + src[(size_t)(32 * db + crow(r, hi)) * 256]; }
    }
    const int sj = tid & 63, sc0 = tid >> 6;
    const int r32_0 = r32, hi_0 = hi, sj_0 = sj;
    for (int ci = 0; ci < 8; ++ci) {
        const size_t tok0 = (size_t)b * SEQ + (size_t)(g * 8 + ci) * 64;
        int r32 = r32_0, hi = hi_0, sj = sj_0; asm volatile("" : "+v"(r32), "+v"(hi), "+v"(sj));
        const float kdec = exp2f((64.f - (float)sj) * lg);
        {
            const bf16_t* rowp = RQK + (tok0 + sj) * 1024 + h * 128;
#pragma unroll
            for (int m = 0; m < 2; ++m) { const int c = sc0 + 8 * m;
                const u32x4 kv = *(const u32x4*)(rowp + 512 + c * 8);
                if (PH2) { const u32x4 qv = *(const u32x4*)(rowp + c * 8);
                    *(LAS u32x4*)(lds + L_Q + sj * PQ + c * 16) = qv; *(LAS u32x4*)(lds + L_K + sj * PQ + c * 16) = kv; }
                const unsigned kw[4] = {kv.x, kv.y, kv.z, kv.w};
#pragma unroll
                for (int q = 0; q < 4; ++q) { const unsigned pk = cvtpk(bflo(kw[q]) * kdec, bfhi(kw[q]) * kdec);
                    *(LAS unsigned short*)(lds + L_KT + (c * 8 + 2 * q) * PT + sj * 2) = (unsigned short)(pk & 0xffffu);
                    *(LAS unsigned short*)(lds + L_KT + (c * 8 + 2 * q + 1) * PT + sj * 2) = (unsigned short)(pk >> 16); } }
            const bf16_t* vrow = RV + (tok0 + sj) * 1024 + h * 256;
#pragma unroll
            for (int m = 0; m < 4; ++m) { const int c = sc0 + 8 * m; const u32x4 vv = *(const u32x4*)(vrow + c * 8);
                const unsigned vw[4] = {vv.x, vv.y, vv.z, vv.w};
#pragma unroll
                for (int q = 0; q < 4; ++q) {
                    *(LAS unsigned short*)(lds + L_VT + (c * 8 + 2 * q) * PT + sj * 2) = (unsigned short)(vw[q] & 0xffffu);
                    *(LAS unsigned short*)(lds + L_VT + (c * 8 + 2 * q + 1) * PT + sj * 2) = (unsigned short)(vw[q] >> 16); } }
        }
        __syncthreads();
        if (PH2) {
            if (w < 4) { const int ib = w >> 1, jb = w & 1; f32x16 s = f32x16{};
#pragma unroll
                for (int k0 = 0; k0 < 8; ++k0) s = MF32(ld16(lds + L_Q + (32 * ib + r32) * PQ + (k0 * 16 + 8 * hi) * 2), ld16(lds + L_K + (32 * jb + r32) * PQ + (k0 * 16 + 8 * hi) * 2), s);
                const int j = 32 * jb + r32;
#pragma unroll
                for (int r = 0; r < 16; ++r) { const int i = 32 * ib + crow(r, hi); const int dd = i > j ? i - j : j - i;
                    const float pv = s[r] * exp2f((float)dd * lg);
                    *(LAS unsigned short*)(lds + L_P + i * PT + j * 2) = (unsigned short)(cvtpk(pv, 0.f) & 0xffffu); } }
            __syncthreads();
            bf16x8 sb[4][2];
#pragma unroll
            for (int db = 0; db < 4; ++db)
#pragma unroll
                for (int kk = 0; kk < 2; ++kk) { u32x4 p; p.x = cvtpk(st[db][8 * kk + 0], st[db][8 * kk + 1]); p.y = cvtpk(st[db][8 * kk + 2], st[db][8 * kk + 3]);
                    p.z = cvtpk(st[db][8 * kk + 4], st[db][8 * kk + 5]); p.w = cvtpk(st[db][8 * kk + 6], st[db][8 * kk + 7]); sb[db][kk] = __builtin_bit_cast(bf16x8, p); }
#pragma unroll
            for (int ib = 0; ib < 2; ++ib) {
                f32x16 ao = f32x16{}, ai = f32x16{};
#pragma unroll
                for (int k0 = 0; k0 < 4; ++k0) ao = MF32(ld16(lds + L_P + (32 * ib + r32) * PT + (k0 * 16 + 8 * hi) * 2), ld16(lds + L_VT + (32 * w + r32) * PT + (k0 * 16 + 8 * hi) * 2), ao);
#pragma unroll
                for (int db = 0; db < 4; ++db)
#pragma unroll
                    for (int kk = 0; kk < 2; ++kk) { const LAS unsigned char* qp = lds + L_Q + (32 * ib + r32) * PQ + (32 * db + 16 * kk + 4 * hi) * 2;
                        const u32x2 lo = *(const LAS u32x2*)qp, hi2 = *(const LAS u32x2*)(qp + 16); u32x4 a; a.x = lo.x; a.y = lo.y; a.z = hi2.x; a.w = hi2.y;
                        ai = MF32(__builtin_bit_cast(bf16x8, a), sb[db][kk], ai); }
                __builtin_amdgcn_sched_barrier(0);
#pragma unroll
                for (int r = 0; r < 16; ++r) { const int i = 32 * ib + crow(r, hi); const float ov = ao[r] + exp2f((float)i * lg) * ai[r];
                    *(LAS unsigned short*)(lds + L_O + i * PO + (32 * w + r32) * 2) = (unsigned short)(cvtpk(ov, 0.f) & 0xffffu); }
                __builtin_amdgcn_sched_barrier(0);
            }
        }
#pragma unroll
        for (int db = 0; db < 4; ++db) { f32x16 s = st[db] * dchunk;
#pragma unroll
            for (int k0 = 0; k0 < 4; ++k0) s = MF32(ld16(lds + L_KT + (32 * db + r32) * PT + (k0 * 16 + 8 * hi) * 2), ld16(lds + L_VT + (32 * w + r32) * PT + (k0 * 16 + 8 * hi) * 2), s);
            st[db] = s; __builtin_amdgcn_sched_barrier(0); }
        __syncthreads();
        if (PH2) {
            int tid_o = tid; asm volatile("" : "+v"(tid_o)); const int i = tid_o >> 3, seg = tid_o & 7;
            const LAS unsigned char* op = lds + L_O + i * PO + seg * 64;
            float v[32]; float ss = 0.f;
#pragma unroll
            for (int q = 0; q < 4; ++q) { const u32x4 ow = *(const LAS u32x4*)(op + q * 16); const unsigned oo[4] = {ow.x, ow.y, ow.z, ow.w};
#pragma unroll
                for (int z = 0; z < 4; ++z) { v[q * 8 + 2 * z] = bflo(oo[z]); v[q * 8 + 2 * z + 1] = bfhi(oo[z]); } }
#pragma unroll
            for (int z = 0; z < 32; ++z) ss += v[z] * v[z];
            ss += __shfl_xor(ss, 1); ss += __shfl_xor(ss, 2); ss += __shfl_xor(ss, 4);
            const float rstd = 1.0f / sqrtf(ss * (1.0f / 256.0f) + EPS);
            bf16_t* yp = YB + (tok0 + i) * 2048 + h * 256 + seg * 32;
#pragma unroll
            for (int q = 0; q < 4; ++q) { const u32x4 gw = *(const u32x4*)(yp + q * 8); const unsigned gg[4] = {gw.x, gw.y, gw.z, gw.w}; u32x4 o;
                unsigned oo[4];
#pragma unroll
                for (int z = 0; z < 4; ++z) oo[z] = cvtpk(bflo(gg[z]) * v[q * 8 + 2 * z] * rstd, bfhi(gg[z]) * v[q * 8 + 2 * z + 1] * rstd);
                o.x = oo[0]; o.y = oo[1]; o.z = oo[2]; o.w = oo[3]; *(u32x4*)(yp + q * 8) = o; }
            __syncthreads();
        }
    }
    if (!PH2) { float* dst = GS + ((size_t)(bh * 16 + g) * 128) * 256 + 32 * w + r32;
#pragma unroll
        for (int db = 0; db < 4; ++db)
#pragma unroll
            for (int r = 0; r < 16; ++r) dst[(size_t)(32 * db + crow(r, hi)) * 256] = st[db][r]; }
}
#undef MF32
}

__device__ __forceinline__ void transpose_item(const float* colp, int ldw, int k0, bf16_t* WT, size_t ldt, int n0, LAS float* scr, int lane) {
#pragma unroll 8
    for (int i = 0; i < 32; ++i) { const int kk = 2 * i + (lane >> 5); scr[kk * 33 + (lane & 31)] = colp[(size_t)(k0 + kk) * ldw]; }
    LDS_WAIT(); asm volatile("" ::: "memory");
    const int c = lane & 7;
#pragma unroll
    for (int j = 0; j < 4; ++j) { const int n = (lane >> 3) + 8 * j; const LAS float* s = scr + (8 * c) * 33 + n;
        u32x4 o; o.x = cvtpk(s[0 * 33], s[1 * 33]); o.y = cvtpk(s[2 * 33], s[3 * 33]); o.z = cvtpk(s[4 * 33], s[5 * 33]); o.w = cvtpk(s[6 * 33], s[7 * 33]);
        *(u32x4*)(WT + (size_t)(n0 + n) * ldt + k0 + 8 * c) = o; }
    LDS_WAIT(); asm volatile("" ::: "memory");
}
__device__ __forceinline__ int in_srccol(int j) {
    if (j < 1024) { const int jj = j & 127; return (j & ~127) + (jj & 1) * 64 + (jj >> 1); }
    if (j < 6144) return j;
    return j + 8;
}
template <bool SILU>
__device__ __forceinline__ void gemv_item(const float* W, int ldw, int col0, const float* v0, const float* v1, const float* bias, float* out0, float* out1, int ostride, LAS float* red) {
    const int tid = threadIdx.x, w = tid >> 6, lane = tid & 63;
    float a0 = 0.f, a1 = 0.f; const float* wp = W + (size_t)(128 * w) * ldw + col0 + lane;
#pragma unroll 8
    for (int k = 0; k < 128; ++k) { float x0 = v0[128 * w + k], x1 = v1[128 * w + k]; if (SILU) { x0 = siluf_(x0); x1 = siluf_(x1); }
        const float wv = wp[(size_t)k * ldw]; a0 += x0 * wv; a1 += x1 * wv; }
    red[(w * 2 + 0) * 64 + lane] = a0; red[(w * 2 + 1) * 64 + lane] = a1;
    __syncthreads();
    if (w == 0) { float s0 = bias ? bias[col0 + lane] : 0.f, s1 = s0;
#pragma unroll
        for (int q = 0; q < 8; ++q) { s0 += red[(q * 2) * 64 + lane]; s1 += red[(q * 2 + 1) * 64 + lane]; }
        out0[(size_t)lane * ostride] = s0; out1[(size_t)lane * ostride] = s1; }
    __syncthreads();
}

struct Args { const float *x, *c, *ada_w, *ada_b, *norm1_w, *w_in, *b_f, *ret_proj, *fox_proj, *w_out, *norm2_w, *w_gate, *w_up, *w_down, *norm_f_w; float* out; unsigned char* ws; };

__global__ void __launch_bounds__(512) mega_fwd(Args a) {
    extern __shared__ __attribute__((aligned(16))) unsigned char lds_raw[];
    cg::grid_group grid = cg::this_grid();
    LAS unsigned char* lds = (LAS unsigned char*)lds_raw;
    const int tid = threadIdx.x, lane = tid & 63, wave = __builtin_amdgcn_readfirstlane(tid >> 6);
    const int G = gridDim.x, bx = blockIdx.x;
    const int vcu = (G % 8 == 0) ? (bx % 8) * (G / 8) + bx / 8 : bx;
    const int gw = vcu * 8 + wave, NGW = G * 8;
    unsigned char* ws = a.ws;
    float* MOD = (float*)(ws + WS_MOD); float* BIAS2 = (float*)(ws + WS_BIAS2); float* LOGF = (float*)(ws + WS_LOGF); float* GC = (float*)(ws + WS_G);
    bf16_t* WIN_T = (bf16_t*)(ws + WS_WIN); bf16_t* PROJ_T = (bf16_t*)(ws + WS_PROJ); bf16_t* WOUT_T = (bf16_t*)(ws + WS_WOUT); bf16_t* WDOWN_T = (bf16_t*)(ws + WS_WDOWN);
    float* SSQ = (float*)(ws + WS_SSQ); bf16_t* HB = (bf16_t*)(ws + WS_H); float* GS = (float*)(ws + WS_H); bf16_t* RQK = (bf16_t*)(ws + WS_RQK); bf16_t* RV = (bf16_t*)(ws + WS_RV);
    bf16_t* YB = (bf16_t*)(ws + WS_YB); bf16_t* FK = (bf16_t*)(ws + WS_FK); bf16_t* FV = (bf16_t*)(ws + WS_FV); bf16_t* GRF = (bf16_t*)a.out;
    bf16_t* MERGED = (bf16_t*)(ws + WS_H); bf16_t* A2 = (bf16_t*)(ws + WS_RQK); bf16_t* ACT = (bf16_t*)(ws + WS_RV); bf16_t* GU_T = (bf16_t*)(ws + WS_WIN);
#define GSYNC() do { __threadfence(); grid.sync(); __builtin_amdgcn_fence(__ATOMIC_ACQUIRE, "agent"); } while (0)

#ifndef NO_P0
    {
        for (int it = bx; it < 96; it += G) gemv_item<true>(a.ada_w, 6144, it * 64, a.c, a.c + 1024, a.ada_b, MOD + it * 64, MOD + 6144 + it * 64, 1, (LAS float*)lds);
        __syncthreads();
        LAS float* scr = (LAS float*)(lds + wave * 16384);
        constexpr int I_IN = 16 * 256, I_P = 16 * 32, I_DN = 44 * 32, NITEMS = I_IN + 3 * I_P + I_DN;
        for (int it = gw; it < NITEMS; it += NGW) {
            int r = it;
            if (r < I_IN) { const int kb = r / 256, nb = r % 256; transpose_item(a.w_in + in_srccol(nb * 32 + (lane & 31)), DINW, kb * 64, WIN_T, 1024, nb * 32, scr, lane); continue; } r -= I_IN;
            if (r < I_P) { const int kb = r / 32, nb = r % 32; transpose_item(a.ret_proj + nb * 32 + (lane & 31), 1024, kb * 64, PROJ_T, 2048, nb * 32, scr, lane); continue; } r -= I_P;
            if (r < I_P) { const int kb = r / 32, nb = r % 32; transpose_item(a.fox_proj + nb * 32 + (lane & 31), 1024, kb * 64, PROJ_T + 1024, 2048, nb * 32, scr, lane); continue; } r -= I_P;
            if (r < I_P) { const int kb = r / 32, nb = r % 32; transpose_item(a.w_out + nb * 32 + (lane & 31), 1024, kb * 64, WOUT_T, 1024, nb * 32, scr, lane); continue; } r -= I_P;
            { const int kb = r / 32, nb = r % 32; transpose_item(a.w_down + nb * 32 + (lane & 31), 1024, kb * 64, WDOWN_T, DFF, nb * 32, scr, lane); }
        }
    }
#endif
    GSYNC();
#ifndef NO_P1
    {
        for (int it = bx; it < 88; it += G) { const int s = it >= 44, cb = (it - 44 * s) * 64;
            gemv_item<false>(s ? a.w_up : a.w_gate, DFF, cb, MOD + 3072, MOD + 6144 + 3072, nullptr, BIAS2 + 2 * cb + s, BIAS2 + NGU + 2 * cb + s, 2, (LAS float*)lds); }
        int lane1 = lane; asm volatile("" : "+v"(lane1));
        float wff[16][8];
#pragma unroll
        for (int j = 0; j < 4; ++j)
#pragma unroll
            for (int q = 0; q < 4; ++q) { const float* p = a.w_in + (size_t)(4 * lane1 + 256 * j + q) * DINW + 6144; const f32x4 w0 = *(const f32x4*)p, w1 = *(const f32x4*)(p + 4);
                wff[4 * j + q][0] = w0[0]; wff[4 * j + q][1] = w0[1]; wff[4 * j + q][2] = w0[2]; wff[4 * j + q][3] = w0[3]; wff[4 * j + q][4] = w1[0]; wff[4 * j + q][5] = w1[1]; wff[4 * j + q][6] = w1[2]; wff[4 * j + q][7] = w1[3]; }
        const float bfl = a.b_f[lane1 & 7];
        for (int m = gw; m < MTOK; m += NGW) {
            const int b = m >> 13; const float* mod = MOD + b * 6144;
            const f32x4* xr = (const f32x4*)(a.x + (size_t)m * DM) + lane1;
            f32x4 v[4]; float s = 0.f;
#pragma unroll
            for (int j = 0; j < 4; ++j) { v[j] = xr[64 * j]; s += (v[j][0] * v[j][0] + v[j][1] * v[j][1]) + (v[j][2] * v[j][2] + v[j][3] * v[j][3]); }
            const float rstd = 1.0f / sqrtf(wave_sum(s) * (1.0f / DM) + EPS);
            float p8[8] = {0.f, 0.f, 0.f, 0.f, 0.f, 0.f, 0.f, 0.f};
            unsigned long long* o8 = (unsigned long long*)(HB + (size_t)m * DM) + lane1;
#pragma unroll
            for (int j = 0; j < 4; ++j) { const int col = 4 * lane1 + 256 * j;
                const f32x4 nw = *(const f32x4*)(a.norm1_w + col), sh = *(const f32x4*)(mod + col), sc = *(const f32x4*)(mod + 1024 + col);
                const f32x4 hv = (v[j] * rstd * nw) * (sc + 1.0f) + sh;
                o8[64 * j] = (unsigned long long)cvtpk(hv[0], hv[1]) | ((unsigned long long)cvtpk(hv[2], hv[3]) << 32);
#pragma unroll
                for (int q = 0; q < 4; ++q)
#pragma unroll
                    for (int hh = 0; hh < 8; ++hh) p8[hh] += hv[q] * wff[4 * j + q][hh]; }
#pragma unroll
            for (int hh = 0; hh < 8; ++hh) p8[hh] = wave_sum(p8[hh]);
            float mine = p8[0];
#pragma unroll
            for (int hh = 1; hh < 8; ++hh) mine = (lane1 & 7) == hh ? p8[hh] : mine;
            if (lane1 < 8) { const float z = mine + bfl; LOGF[(size_t)m * 8 + lane1] = fminf(z, 0.f) - log1pf(__expf(-fabsf(z))); }
        }
    }
#endif
    GSYNC();
#ifndef NO_P2
    {
        if (bx < 16) {
            const int b = bx >> 3, hh = bx & 7; const int s0 = tid * 16; float vals[16]; double tot = 0.0;
#pragma unroll
            for (int i = 0; i < 16; ++i) { vals[i] = LOGF[((size_t)b * SEQ + s0 + i) * 8 + hh]; tot += (double)vals[i]; }
            double incl = tot;
#pragma unroll
            for (int o = 1; o < 64; o <<= 1) { const double t2 = __shfl_up(incl, o); if (lane >= o) incl += t2; }
            LAS double* wsum = (LAS double*)lds;
            if (lane == 63) wsum[wave] = incl;
            __syncthreads();
            double run = incl - tot;
            for (int q = 0; q < wave; ++q) run += wsum[q];
#pragma unroll
            for (int i = 0; i < 16; ++i) { run += (double)vals[i]; GC[(size_t)bx * SEQ + s0 + i] = (float)(run * 11.313708498984761); }
            __syncthreads();
        }
        pg8::Gemm g{HB, WIN_T, MTOK, NIN, DM}; pg8::StaticOrder S; S.init(MTOK, NIN, G, bx);
        EpiIn E{RQK, RV, YB, FK, FV, GRF};
        pg8::gemm_phase<EpiIn, pg8::StaticOrder>(lds, g, S, E);
    }
#endif
    GSYNC();
#ifndef NO_P3A
    {
        LAS float* scr = (LAS float*)(lds + wave * 16384);
        for (int it = gw; it < 16 * 176; it += NGW) { const int kb = it / 176, nb = it % 176; const int np = nb * 32 + (lane & 31);
            transpose_item(((np & 1) ? a.w_up : a.w_gate) + (np >> 1), DFF, kb * 64, GU_T, 1024, nb * 32, scr, lane); }
        __syncthreads();
        for (int u = bx; u < 120; u += G) { const int bh = u / 15, g = u % 15; ret::unit<false>(bh, g, RQK, RV, YB, GS, lds); }
    }
#endif
    GSYNC();
#ifndef NO_P3B
    {
#ifndef NO_RET2
        for (int u = bx; u < 128; u += G) ret::unit<true>(u >> 4, u & 15, RQK, RV, YB, GS, lds);
        __syncthreads();
#endif
#ifndef NO_ATT
        char* alds = (char*)lds_raw;
        if (vcu < 256) {
            int L = vcu, pass = 0;
#define FOX_REF(R, L_, pass_) do { const int bh_ = (L_) >> 4, x_ = (L_) & 15, b_ = bh_ >> 3, h_ = bh_ & 7, qb_ = (pass_) ? 31 - x_ : x_; \
                (R).K = FK + (size_t)b_ * SEQ * 1024 + h_ * 128; (R).V = FV + (size_t)b_ * SEQ * 1024 + h_ * 128; (R).G = GC + (size_t)bh_ * SEQ; \
                (R).Q = YB + ((size_t)b_ * SEQ + (size_t)qb_ * 256) * 2048 + 1024 + h_ * 128; (R).O = const_cast<bf16_t*>((R).Q); (R).P0 = qb_ * 256; } while (0)
            fox::BlockRef cur; FOX_REF(cur, L, 0);
            fox::Seam S;
            fox::prime(cur, alds, S);
            for (;;) {
                const bool more_pass = pass == 0, more_item = L + G < 256, last = !more_pass && !more_item;
                int Ln = L, passn = pass + 1; if (!more_pass) { passn = 0; Ln = more_item ? L + G : L; }
                fox::BlockRef nxt = cur; if (!last) FOX_REF(nxt, Ln, passn);
                fox::block(cur, nxt, alds, S);
                if (last) break;
                cur = nxt; L = Ln; pass = passn;
            }
#undef FOX_REF
            asm volatile("s_waitcnt vmcnt(0)" ::: "memory");
            __syncthreads();
        }
#endif
    }
#endif
    GSYNC();
#ifndef NO_P4
    {
        pg8::Gemm g{YB, PROJ_T, MTOK, DM, 2048}; pg8::StaticOrder S; S.init(MTOK, DM, G, bx);
        EpiMerge E{GRF, MERGED};
        pg8::gemm_phase<EpiMerge, pg8::StaticOrder>(lds, g, S, E);
    }
#endif
    GSYNC();
#ifndef NO_P5
    {
        pg8::Gemm g{MERGED, WOUT_T, MTOK, DM, DM}; pg8::StaticOrder S; S.init(MTOK, DM, G, bx);
        EpiWout E{a.x, MOD, a.norm2_w, a.out, A2, SSQ};
        pg8::gemm_phase<EpiWout, pg8::StaticOrder>(lds, g, S, E);
    }
#endif
    GSYNC();
#ifndef NO_P6
    {
        pg8::Gemm g{A2, GU_T, MTOK, NGU, DM}; pg8::StaticOrder S; S.init(MTOK, NGU, G, bx);
        EpiGU E{SSQ, BIAS2, ACT};
        pg8::gemm_phase<EpiGU, pg8::StaticOrder>(lds, g, S, E);
    }
#endif
    GSYNC();
#ifndef NO_P7
    {
        pg8::Gemm g{ACT, WDOWN_T, MTOK, DM, DFF}; pg8::StaticOrder S; S.init(MTOK, DM, G, bx);
        EpiDown E{MOD, a.out};
        pg8::gemm_phase<EpiDown, pg8::StaticOrder>(lds, g, S, E);
    }
#endif
    GSYNC();
#ifndef NO_P8
    {
        int lane8 = lane; asm volatile("" : "+v"(lane8));
        for (int m = gw; m < MTOK; m += NGW) {
            f32x4* xr = (f32x4*)(a.out + (size_t)m * DM) + lane8;
            f32x4 v[4]; float s = 0.f;
#pragma unroll
            for (int j = 0; j < 4; ++j) { v[j] = xr[64 * j]; s += (v[j][0] * v[j][0] + v[j][1] * v[j][1]) + (v[j][2] * v[j][2] + v[j][3] * v[j][3]); }
            const float rstd = 1.0f / sqrtf(wave_sum(s) * (1.0f / DM) + EPS);
#pragma unroll
            for (int j = 0; j < 4; ++j) { const f32x4 nw = *(const f32x4*)(a.norm_f_w + 4 * lane8 + 256 * j); xr[64 * j] = v[j] * rstd * nw; }
        }
    }
#endif
}

extern "C" void kernel_launch(void* const* d_in, const int* in_sizes, int n_in, void* d_out, int out_size, void* d_ws, size_t ws_size, hipStream_t stream) {
    static int grid = 0;
    if (grid == 0) {
        if (n_in != 15 || out_size != MTOK * DM || ws_size < WS_END) { fprintf(stderr, "kernel_launch: unexpected shapes (n_in %d out %d ws %zu)\n", n_in, out_size, ws_size); grid = -1; return; }
        int dev = 0, cus = 0, per_cu = 0;
        (void)hipGetDevice(&dev); (void)hipDeviceGetAttribute(&cus, hipDeviceAttributeMultiprocessorCount, dev);
        (void)hipFuncSetAttribute((const void*)mega_fwd, hipFuncAttributeMaxDynamicSharedMemorySize, LDS_BYTES);
        if (hipOccupancyMaxActiveBlocksPerMultiprocessor(&per_cu, (const void*)mega_fwd, 512, LDS_BYTES) != hipSuccess || per_cu < 1) { fprintf(stderr, "kernel_launch: occupancy query failed\n"); per_cu = 1; }
        (void)hipGetLastError();
        if (per_cu > 1) per_cu = 1;
        grid = cus * per_cu;
    }
    if (grid < 0) return;
    Args a{};
    a.x = (const float*)d_in[0]; a.c = (const float*)d_in[1]; a.ada_w = (const float*)d_in[2]; a.ada_b = (const float*)d_in[3]; a.norm1_w = (const float*)d_in[4];
    a.w_in = (const float*)d_in[5]; a.b_f = (const float*)d_in[6]; a.ret_proj = (const float*)d_in[7]; a.fox_proj = (const float*)d_in[8]; a.w_out = (const float*)d_in[9];
    a.norm2_w = (const float*)d_in[10]; a.w_gate = (const float*)d_in[11]; a.w_up = (const float*)d_in[12]; a.w_down = (const float*)d_in[13]; a.norm_f_w = (const float*)d_in[14];
    a.out = (float*)d_out; a.ws = (unsigned char*)d_ws;
    void* args[] = {&a};
    hipError_t e = hipLaunchCooperativeKernel((const void*)mega_fwd, dim3(grid), dim3(512), args, LDS_BYTES, stream);
    if (e != hipSuccess) fprintf(stderr, "kernel_launch: cooperative launch failed: %s (grid %d)\n", hipGetErrorString(e), grid);
}
```

```cpp
#include <hip/hip_runtime.h>
#include <hip/hip_cooperative_groups.h>
#include <hip/hip_bf16.h>
#include <cstdio>
#include <cstdint>
namespace cg = cooperative_groups;
#ifndef PROBE_A
#define PROBE_A 0
#endif
#ifndef PROBE_G
#define PROBE_G 0
#endif
#ifndef PROBE_R
#define PROBE_R 0
#endif
#ifndef PROBE_T
#define PROBE_T 0
#endif
#ifndef PROBE_D
#define PROBE_D 0
#endif
#ifndef PROBE_S
#define PROBE_S 0
#endif
#ifndef PROBE_F
#define PROBE_F 0
#endif
#define REPEAT(flag) for (int rep_ = 0; rep_ < ((flag) ? 2 : 1); ++rep_)

#define LAS __attribute__((address_space(3)))
typedef unsigned short bf16_t;
typedef short bf16x8 __attribute__((ext_vector_type(8)));
typedef short s16x4 __attribute__((ext_vector_type(4)));
typedef float f32x2 __attribute__((ext_vector_type(2)));
typedef float f32x4 __attribute__((ext_vector_type(4)));
typedef float f32x16 __attribute__((ext_vector_type(16)));
typedef unsigned u32x2 __attribute__((ext_vector_type(2)));
typedef unsigned u32x4 __attribute__((ext_vector_type(4)));
typedef __bf16 bf16x2_t __attribute__((ext_vector_type(2)));

constexpr int SEQ = 8192, DM = 1024, MTOK = 2 * SEQ, DFF = 2816, NGU = 2 * DFF, DINW = 8200, NIN = 8192;
constexpr float EPS = 1e-6f;
constexpr size_t MiB = 1u << 20;
constexpr size_t WS_MOD = 0;
constexpr size_t WS_BIAS2 = 64 * 1024;
constexpr size_t WS_LOGF = 128 * 1024;
constexpr size_t WS_G = 640 * 1024;
constexpr size_t WS_BAR = 1536 * 1024;
constexpr size_t WS_WIN = 2 * MiB;
constexpr size_t WS_PROJ = 18 * MiB;
constexpr size_t WS_WOUT = 22 * MiB;
constexpr size_t WS_WDOWN = 24 * MiB;
constexpr size_t WS_SSQ = 30 * MiB;
constexpr size_t WS_H = 32 * MiB;
constexpr size_t WS_RQK = 64 * MiB;
constexpr size_t WS_RV = 96 * MiB;
constexpr size_t WS_YB = 128 * MiB;
constexpr size_t WS_FK = 192 * MiB;
constexpr size_t WS_FV = 224 * MiB;
constexpr size_t WS_END = 256 * MiB;
constexpr int LDS_BYTES = 147456;

__device__ __forceinline__ unsigned cvtpk(float lo, float hi) { f32x2 v = {lo, hi}; bf16x2_t b = __builtin_convertvector(v, bf16x2_t); return __builtin_bit_cast(unsigned, b); }
__device__ __forceinline__ float bf2f(unsigned short b) { return __uint_as_float((unsigned)b << 16); }
__device__ __forceinline__ float bflo(unsigned w) { return __uint_as_float(w << 16); }
__device__ __forceinline__ float bfhi(unsigned w) { return __uint_as_float(w & 0xffff0000u); }
__device__ __forceinline__ float sigmoidf_(float x) { return 1.f / (1.f + __expf(-x)); }
__device__ __forceinline__ float siluf_(float x) { return x / (1.f + __expf(-x)); }
__device__ __forceinline__ float wave_sum(float v) {
#pragma unroll
    for (int o = 1; o < 64; o <<= 1) v += __shfl_xor(v, o);
    return v;
}
#define LDS_WAIT() asm volatile("s_waitcnt lgkmcnt(0)" ::: "memory")

namespace pg8 {
#define PG8_LAS __attribute__((address_space(3)))
constexpr int BM = 256, BK = 64, HALF = 128, HTB = HALF * BK * 2, STAGE_BYTES = 8 * HTB, NXCD = 8, WGM = 8;
__host__ __device__ __forceinline__ int lds_byte(int r, int c) { const int st = (r >> 4) * 2 + (c >> 5), rr = r & 15, cc = c & 31, ob = rr * 64 + cc * 2; return st * 1024 + (ob ^ (((ob >> 9) & 1) << 5)); }
__host__ __device__ __forceinline__ void stage_rc(int b, int& R, int& C) { const int st = b / 1024, sb = b % 1024, swz = sb ^ (((sb >> 9) & 1) << 5); R = (st >> 1) * 16 + swz / 64; C = (st & 1) * 32 + (swz % 64) / 2; }
__host__ __device__ __forceinline__ int perm32(int rho) { const int n = rho >> 4, i = rho & 15; return 8 * (i >> 2) + 4 * n + (i & 3); }
struct Unit { int pm, pn; };
struct Gemm { const bf16_t* A; const bf16_t* Bt; int M, N, K; };
struct StaticOrder {
    int nM, nN, nwg, G, c;
    __host__ __device__ void init(int M, int N, int G_, int c_) { nM = M / BM; nN = N / BM; nwg = nM * nN; G = G_; c = c_; }
    __host__ __device__ bool next(int i, Unit& u) const {
        const long L = (long)i * G + c; if (L >= nwg) return false;
        int wgid = (int)L; { const int q = nwg / NXCD, r = nwg % NXCD, xcd = wgid % NXCD, off = wgid / NXCD; wgid = (xcd < r ? xcd * (q + 1) : r * (q + 1) + (xcd - r) * q) + off; }
        const int nig = WGM * nN, gid = wgid / nig, fm = gid * WGM, gsz = (nM - fm) < WGM ? (nM - fm) : WGM;
        u.pm = fm + ((wgid % nig) % gsz); u.pn = (wgid % nig) / gsz; return true;
    }
};
template <class Epi, class Sched>
__device__ __forceinline__ void gemm_phase(PG8_LAS unsigned char* lds, const Gemm g, const Sched& S, const Epi& E) {
    int tid = threadIdx.x; asm volatile("" : "+v"(tid));
    const int wid = __builtin_amdgcn_readfirstlane(tid >> 6), lane = tid & 63, wr = wid >> 2, wc = wid & 3; int fr = lane & 15, fq = lane >> 4;
    const int K = g.K, nt = K / BK;
    unsigned voffA[2], voffB[2];
#pragma unroll
    for (int i = 0; i < 2; ++i) { int R, C; stage_rc(tid * 16 + i * 8192, R, C); const int Rb = (R & ~31) + perm32(R & 31);
        voffA[i] = (unsigned)(R * K + C) * 2u; voffB[i] = (unsigned)(Rb * K + C) * 2u; }
    const size_t kstep = (size_t)(BK * 2);
    const size_t hstep = (size_t)HALF * K * 2;
    const size_t tstep = 2 * hstep;
    const unsigned ldsw = (unsigned)wid * 1024u;
    const int aoff = lds_byte(wr * 64 + fr, fq * 8), boff = lds_byte(wc * 32 + fr, fq * 8);
#define PG8_SA(b, h) (((b) * 2 + (h)) * HTB)
#define PG8_SB(b, h) ((4 + (b) * 2 + (h)) * HTB)
#define PG8_STAGE(bufoff, gbase, voff) do { _Pragma("unroll") for (int _i = 0; _i < 2; ++_i) \
        __builtin_amdgcn_global_load_lds((const unsigned*)((const char*)(gbase) + (voff)[_i]), (PG8_LAS unsigned*)(lds + (bufoff) + ldsw + _i * 8192), 16, 0, 0); } while (0)
#define PG8_LDA(dst, b, h) do { _Pragma("unroll") for (int m = 0; m < 4; ++m) _Pragma("unroll") for (int k = 0; k < 2; ++k) dst[m][k] = *(const PG8_LAS bf16x8*)(lds + PG8_SA(b, h) + aoff + m * 2048 + k * 1024); } while (0)
#define PG8_LDB(dst, b, h) do { _Pragma("unroll") for (int n = 0; n < 2; ++n) _Pragma("unroll") for (int k = 0; k < 2; ++k) dst[n][k] = *(const PG8_LAS bf16x8*)(lds + PG8_SB(b, h) + boff + n * 2048 + k * 1024); } while (0)
#define PG8_MMA(ai, bj, At, Bt) do { __builtin_amdgcn_s_setprio(1); _Pragma("unroll") for (int m = 0; m < 4; ++m) _Pragma("unroll") for (int n = 0; n < 2; ++n) _Pragma("unroll") for (int k = 0; k < 2; ++k) \
        acc[ai][bj][m][n] = __builtin_amdgcn_mfma_f32_16x16x32_bf16(Bt[n][k], At[m][k], acc[ai][bj][m][n], 0, 0, 0); __builtin_amdgcn_s_setprio(0); } while (0)
#define PG8_WAIT_V(n) asm volatile("s_waitcnt vmcnt(" #n ")" ::: "memory")
#define PG8_WAIT_L(n) asm volatile("s_waitcnt lgkmcnt(" #n ")" ::: "memory")
#define PG8_BAR __builtin_amdgcn_s_barrier()
#define PG8_SCHED __builtin_amdgcn_sched_barrier(0)
    Unit cur, nxt; int ui = 0;
    if (!S.next(0, cur)) return;
    f32x4 acc[2][2][4][2];
#pragma unroll
    for (int a = 0; a < 2; ++a)
#pragma unroll
        for (int b = 0; b < 2; ++b)
#pragma unroll
            for (int m = 0; m < 4; ++m)
#pragma unroll
                for (int n = 0; n < 2; ++n) acc[a][b][m][n] = (f32x4){0.f, 0.f, 0.f, 0.f};
    bf16x8 At[4][2], B0[2][2], B1[2][2];
    const char* cA = (const char*)g.A + (size_t)cur.pm * tstep; const char* cB = (const char*)g.Bt + (size_t)cur.pn * tstep;
    PG8_STAGE(PG8_SB(0, 0), cB, voffB); PG8_STAGE(PG8_SB(0, 1), cB + hstep, voffB); PG8_STAGE(PG8_SA(0, 0), cA, voffA); PG8_STAGE(PG8_SA(0, 1), cA + hstep, voffA);
    if (wr == 1) PG8_BAR;
    PG8_WAIT_V(2); PG8_BAR;
    PG8_STAGE(PG8_SB(1, 0), cB + kstep, voffB); PG8_STAGE(PG8_SA(1, 0), cA + kstep, voffA); PG8_STAGE(PG8_SB(1, 1), cB + hstep + kstep, voffB);
    PG8_WAIT_V(6); PG8_BAR;
    for (;;) {
        const bool has_next = S.next(ui + 1, nxt);
        const char* nA = has_next ? (const char*)g.A + (size_t)nxt.pm * tstep : cA; const char* nB = has_next ? (const char*)g.Bt + (size_t)nxt.pn * tstep : cB;
        for (int t = 0; t < nt; t += 2) {
            const bool last = (t == nt - 2);
            const char* a1 = cA + (size_t)(t + 1) * kstep;
            const char* a2 = last ? nA : cA + (size_t)(t + 2) * kstep; const char* b2 = last ? nB : cB + (size_t)(t + 2) * kstep;
            const char* a3 = a2 + kstep; const char* b3 = b2 + kstep;
            if constexpr (Epi::MIDK) { if (t == nt / 2) E.mid(acc, cur, wr, wc, fr, fq); }
            PG8_LDB(B0, 0, 0); PG8_LDB(B1, 0, 1); PG8_SCHED; PG8_LDA(At, 0, 0); PG8_STAGE(PG8_SA(1, 1), a1 + hstep, voffA);
            PG8_WAIT_V(8); PG8_WAIT_L(0); PG8_BAR; PG8_MMA(0, 0, At, B0); PG8_MMA(0, 1, At, B1); PG8_BAR; PG8_SCHED;
            PG8_LDA(At, 0, 1); PG8_STAGE(PG8_SB(0, 0), b2, voffB); PG8_STAGE(PG8_SB(0, 1), b2 + hstep, voffB); PG8_STAGE(PG8_SA(0, 0), a2, voffA);
            PG8_WAIT_V(8); PG8_WAIT_L(0); PG8_BAR; PG8_MMA(1, 0, At, B0); PG8_MMA(1, 1, At, B1); PG8_BAR; PG8_SCHED;
            PG8_LDB(B0, 1, 0); PG8_LDB(B1, 1, 1); PG8_SCHED; PG8_LDA(At, 1, 0); PG8_STAGE(PG8_SA(0, 1), a2 + hstep, voffA);
            PG8_WAIT_V(8); PG8_WAIT_L(0); PG8_BAR; PG8_MMA(0, 0, At, B0); PG8_MMA(0, 1, At, B1); PG8_BAR; PG8_SCHED;
            PG8_LDA(At, 1, 1); PG8_STAGE(PG8_SB(1, 0), b3, voffB); PG8_STAGE(PG8_SB(1, 1), b3 + hstep, voffB); PG8_STAGE(PG8_SA(1, 0), a3, voffA);
            PG8_WAIT_V(8); PG8_WAIT_L(0); PG8_BAR; PG8_MMA(1, 0, At, B0); PG8_MMA(1, 1, At, B1); PG8_BAR; PG8_SCHED;
        }
        if (wr == 0) PG8_BAR;
        E(acc, cur, wr, wc, fr, fq);
        if (!has_next) break;
#pragma unroll
        for (int a = 0; a < 2; ++a)
#pragma unroll
            for (int b = 0; b < 2; ++b)
#pragma unroll
                for (int m = 0; m < 4; ++m)
#pragma unroll
                    for (int n = 0; n < 2; ++n) acc[a][b][m][n] = (f32x4){0.f, 0.f, 0.f, 0.f};
        cur = nxt; cA = nA; cB = nB; ++ui;
        if (wr == 1) PG8_BAR;
    }
    PG8_WAIT_V(0);
    PG8_BAR;
#undef PG8_SA
#undef PG8_SB
#undef PG8_STAGE
#undef PG8_LDA
#undef PG8_LDB
#undef PG8_MMA
#undef PG8_WAIT_V
#undef PG8_WAIT_L
#undef PG8_BAR
#undef PG8_SCHED
}
}

typedef const f32x4 (&AccRef)[2][2][4][2];
typedef f32x4 (&AccMut)[2][2][4][2];
__device__ __forceinline__ u32x4 pack8(f32x4 a, f32x4 b) { u32x4 w; w.x = cvtpk(a[0], a[1]); w.y = cvtpk(a[2], a[3]); w.z = cvtpk(b[0], b[1]); w.w = cvtpk(b[2], b[3]); return w; }

struct EpiIn {
    static constexpr bool MIDK = false;
    bf16_t *RQK, *RV, *YB, *FK, *FV, *GRF;
    __device__ __forceinline__ void mid(AccMut, const pg8::Unit&, int, int, int, int) const {}
    __device__ __forceinline__ void operator()(AccRef acc, const pg8::Unit& u, int wr, int wc, int fr, int fq) const {
        const int pn = u.pn; int mode = 0, pitch = 1024, coff; bf16_t* base;
        if (pn < 4) { mode = pn < 2 ? 1 : 2; base = RQK; coff = pn * 256; }
        else if (pn < 8) { base = RV; coff = (pn - 4) * 256; }
        else if (pn < 12) { mode = 3; base = YB; pitch = 2048; coff = (pn - 8) * 256; }
        else if (pn < 16) { base = YB; pitch = 2048; coff = 1024 + (pn - 12) * 256; }
        else if (pn < 20) { base = FK; coff = (pn - 16) * 256; }
        else if (pn < 24) { base = FV; coff = (pn - 20) * 256; }
        else { mode = 4; base = GRF; pitch = 2048; coff = (pn - 24) * 256; }
        asm volatile("" : "+v"(fr), "+v"(fq));
        const int row0 = u.pm * 256 + wr * 64 + fr, col0 = coff + wc * 32 + 8 * fq;
        if (mode == 1 || mode == 2) {
            float fr4[4];
#pragma unroll
            for (int p = 0; p < 4; ++p) fr4[p] = powf(10000.0f, -(float)(16 * wc + 4 * fq + p) * (1.0f / 64.0f));
            const float ks = mode == 2 ? 0.08838834764831845f : 1.0f;
#pragma unroll
            for (int ai = 0; ai < 2; ++ai)
#pragma unroll
                for (int m = 0; m < 4; ++m) {
                    const int row = row0 + ai * 128 + m * 16; const float pos = (float)(row & (SEQ - 1));
                    float cs[4], sn[4];
#pragma unroll
                    for (int p = 0; p < 4; ++p) { const float ang = pos * fr4[p]; double t = (double)ang * 0.15915494309189535; t -= floor(t); const float tf = (float)t;
                        sn[p] = __builtin_amdgcn_sinf(tf) * ks; cs[p] = __builtin_amdgcn_cosf(tf) * ks; }
#pragma unroll
                    for (int bj = 0; bj < 2; ++bj) { const f32x4 v0 = acc[ai][bj][m][0], v1 = acc[ai][bj][m][1]; f32x4 o0, o1;
                        o0[0] = v0[0] * cs[0] - v0[1] * sn[0]; o0[1] = v0[0] * sn[0] + v0[1] * cs[0];
                        o0[2] = v0[2] * cs[1] - v0[3] * sn[1]; o0[3] = v0[2] * sn[1] + v0[3] * cs[1];
                        o1[0] = v1[0] * cs[2] - v1[1] * sn[2]; o1[1] = v1[0] * sn[2] + v1[1] * cs[2];
                        o1[2] = v1[2] * cs[3] - v1[3] * sn[3]; o1[3] = v1[2] * sn[3] + v1[3] * cs[3];
                        *(u32x4*)(base + (size_t)row * pitch + col0 + bj * 128) = pack8(o0, o1); }
                }
        } else {
#pragma unroll
            for (int ai = 0; ai < 2; ++ai)
#pragma unroll
                for (int m = 0; m < 4; ++m) {
                    const int row = row0 + ai * 128 + m * 16;
#pragma unroll
                    for (int bj = 0; bj < 2; ++bj) { f32x4 v0 = acc[ai][bj][m][0], v1 = acc[ai][bj][m][1];
                        if (mode == 3) {
#pragma unroll
                            for (int q = 0; q < 4; ++q) { v0[q] = siluf_(v0[q]); v1[q] = siluf_(v1[q]); } }
                        else if (mode == 4) {
#pragma unroll
                            for (int q = 0; q < 4; ++q) { v0[q] = sigmoidf_(v0[q]); v1[q] = sigmoidf_(v1[q]); } }
                        *(u32x4*)(base + (size_t)row * pitch + col0 + bj * 128) = pack8(v0, v1); }
                }
        }
    }
};
struct EpiMerge {
    static constexpr bool MIDK = true;
    const bf16_t* GRF; bf16_t* OUT;
    __device__ __forceinline__ void mid(AccMut acc, const pg8::Unit& u, int wr, int wc, int fr, int fq) const {
        asm volatile("" : "+v"(fr), "+v"(fq));
        const int row0 = u.pm * 256 + wr * 64 + fr, col0 = u.pn * 256 + wc * 32 + 8 * fq;
#pragma unroll
        for (int ai = 0; ai < 2; ++ai)
#pragma unroll
            for (int m = 0; m < 4; ++m) { const int row = row0 + ai * 128 + m * 16;
#pragma unroll
                for (int bj = 0; bj < 2; ++bj) { const u32x4 gr = *(const u32x4*)(GRF + (size_t)row * 2048 + col0 + bj * 128), gf = *(const u32x4*)(GRF + (size_t)row * 2048 + 1024 + col0 + bj * 128);
                    f32x4 r0, r1;
                    r0[0] = bflo(gr.x) / bflo(gf.x); r0[1] = bfhi(gr.x) / bfhi(gf.x); r0[2] = bflo(gr.y) / bflo(gf.y); r0[3] = bfhi(gr.y) / bfhi(gf.y);
                    r1[0] = bflo(gr.z) / bflo(gf.z); r1[1] = bfhi(gr.z) / bfhi(gf.z); r1[2] = bflo(gr.w) / bflo(gf.w); r1[3] = bfhi(gr.w) / bfhi(gf.w);
                    acc[ai][bj][m][0] *= r0; acc[ai][bj][m][1] *= r1; }
                __builtin_amdgcn_sched_barrier(0); }
    }
    __device__ __forceinline__ void operator()(AccRef acc, const pg8::Unit& u, int wr, int wc, int fr, int fq) const {
        asm volatile("" : "+v"(fr), "+v"(fq));
        const int row0 = u.pm * 256 + wr * 64 + fr, col0 = u.pn * 256 + wc * 32 + 8 * fq;
#pragma unroll
        for (int ai = 0; ai < 2; ++ai)
#pragma unroll
            for (int m = 0; m < 4; ++m) { const int row = row0 + ai * 128 + m * 16;
#pragma unroll
                for (int bj = 0; bj < 2; ++bj) { const u32x4 gf = *(const u32x4*)(GRF + (size_t)row * 2048 + 1024 + col0 + bj * 128);
                    f32x4 r0, r1; r0[0] = bflo(gf.x); r0[1] = bfhi(gf.x); r0[2] = bflo(gf.y); r0[3] = bfhi(gf.y); r1[0] = bflo(gf.z); r1[1] = bfhi(gf.z); r1[2] = bflo(gf.w); r1[3] = bfhi(gf.w);
                    *(u32x4*)(OUT + (size_t)row * 1024 + col0 + bj * 128) = pack8(acc[ai][bj][m][0] * r0, acc[ai][bj][m][1] * r1); } }
    }
};
struct EpiWout {
    static constexpr bool MIDK = false;
    const float* X; const float* MOD; const float* N2W; float* X1; bf16_t* A2; float* SSQ;
    __device__ __forceinline__ void mid(AccMut, const pg8::Unit&, int, int, int, int) const {}
    __device__ __forceinline__ void operator()(AccRef acc, const pg8::Unit& u, int wr, int wc, int fr, int fq) const {
        asm volatile("" : "+v"(fr), "+v"(fq));
        const int row0 = u.pm * 256 + wr * 64 + fr, col0 = u.pn * 256 + wc * 32 + 8 * fq; const int b = u.pm >> 5;
        const float* mod = MOD + b * 6144;
        f32x4 g1[2][2], w2[2][2];
#pragma unroll
        for (int bj = 0; bj < 2; ++bj)
#pragma unroll
            for (int n = 0; n < 2; ++n) { const int c = col0 + bj * 128 + 4 * n; g1[bj][n] = *(const f32x4*)(mod + 2048 + c);
                const f32x4 sc = *(const f32x4*)(mod + 4096 + c), nw = *(const f32x4*)(N2W + c); w2[bj][n] = nw * (sc + 1.0f); }
#pragma unroll
        for (int ai = 0; ai < 2; ++ai)
#pragma unroll
            for (int m = 0; m < 4; ++m) { const int row = row0 + ai * 128 + m * 16; float ss = 0.f;
#pragma unroll
                for (int bj = 0; bj < 2; ++bj) { const size_t off = (size_t)row * 1024 + col0 + bj * 128;
                    const f32x4 x0 = *(const f32x4*)(X + off), x1v = *(const f32x4*)(X + off + 4);
                    const f32x4 y0 = x0 + g1[bj][0] * acc[ai][bj][m][0], y1 = x1v + g1[bj][1] * acc[ai][bj][m][1];
                    *(f32x4*)(X1 + off) = y0; *(f32x4*)(X1 + off + 4) = y1;
                    ss += (y0[0] * y0[0] + y0[1] * y0[1]) + (y0[2] * y0[2] + y0[3] * y0[3]) + (y1[0] * y1[0] + y1[1] * y1[1]) + (y1[2] * y1[2] + y1[3] * y1[3]);
                    *(u32x4*)(A2 + off) = pack8(y0 * w2[bj][0], y1 * w2[bj][1]); }
                ss += __shfl_xor(ss, 16); ss += __shfl_xor(ss, 32);
                if (fq == 0) SSQ[(size_t)row * 16 + u.pn * 4 + wc] = ss; }
    }
};
struct EpiGU {
    static constexpr bool MIDK = false;
    const float* SSQ; const float* BIAS2; bf16_t* ACT;
    __device__ __forceinline__ void mid(AccMut, const pg8::Unit&, int, int, int, int) const {}
    __device__ __forceinline__ void operator()(AccRef acc, const pg8::Unit& u, int wr, int wc, int fr, int fq) const {
        asm volatile("" : "+v"(fr), "+v"(fq));
        const int row0 = u.pm * 256 + wr * 64 + fr, col0 = u.pn * 256 + wc * 32 + 8 * fq; const int b = u.pm >> 5;
        const float* bias = BIAS2 + b * NGU;
        f32x4 bv[2][2];
#pragma unroll
        for (int bj = 0; bj < 2; ++bj)
#pragma unroll
            for (int n = 0; n < 2; ++n) bv[bj][n] = *(const f32x4*)(bias + col0 + bj * 128 + 4 * n);
#pragma unroll
        for (int ai = 0; ai < 2; ++ai)
#pragma unroll
            for (int m = 0; m < 4; ++m) { const int row = row0 + ai * 128 + m * 16;
                const f32x4* sp = (const f32x4*)(SSQ + (size_t)row * 16); const f32x4 s0 = sp[0], s1 = sp[1], s2 = sp[2], s3 = sp[3];
                const float tot = ((s0[0] + s0[1]) + (s0[2] + s0[3])) + ((s1[0] + s1[1]) + (s1[2] + s1[3])) + ((s2[0] + s2[1]) + (s2[2] + s2[3])) + ((s3[0] + s3[1]) + (s3[2] + s3[3]));
                const float rstd = 1.0f / sqrtf(tot * (1.0f / 1024.0f) + EPS);
#pragma unroll
                for (int bj = 0; bj < 2; ++bj) { const f32x4 v0 = acc[ai][bj][m][0] * rstd + bv[bj][0], v1 = acc[ai][bj][m][1] * rstd + bv[bj][1];
                    u32x2 w; w.x = cvtpk(siluf_(v0[0]) * v0[1], siluf_(v0[2]) * v0[3]); w.y = cvtpk(siluf_(v1[0]) * v1[1], siluf_(v1[2]) * v1[3]);
                    *(u32x2*)(ACT + (size_t)row * DFF + ((col0 + bj * 128) >> 1)) = w; } }
    }
};
struct EpiDown {
    static constexpr bool MIDK = false;
    const float* MOD; float* X1; float* OUT;
    __device__ __forceinline__ void mid(AccMut, const pg8::Unit&, int, int, int, int) const {}
    __device__ __forceinline__ void operator()(AccRef acc, const pg8::Unit& u, int wr, int wc, int fr, int fq) const {
        asm volatile("" : "+v"(fr), "+v"(fq));
        const int row0 = u.pm * 256 + wr * 64 + fr, col0 = u.pn * 256 + wc * 32 + 8 * fq; const int b = u.pm >> 5;
        const float* mod = MOD + b * 6144 + 5120;
        f32x4 g2[2][2];
#pragma unroll
        for (int bj = 0; bj < 2; ++bj)
#pragma unroll
            for (int n = 0; n < 2; ++n) g2[bj][n] = *(const f32x4*)(mod + col0 + bj * 128 + 4 * n);
#pragma unroll
        for (int ai = 0; ai < 2; ++ai)
#pragma unroll
            for (int m = 0; m < 4; ++m) { const int row = row0 + ai * 128 + m * 16;
#pragma unroll
                for (int bj = 0; bj < 2; ++bj) { const size_t off = (size_t)row * 1024 + col0 + bj * 128;
                    const f32x4 x0 = *(const f32x4*)(X1 + off), x1v = *(const f32x4*)(X1 + off + 4);
                    *(f32x4*)(OUT + off) = x0 + g2[bj][0] * acc[ai][bj][m][0]; *(f32x4*)(OUT + off + 4) = x1v + g2[bj][1] * acc[ai][bj][m][1]; } }
    }
};

namespace fox {
constexpr int D = 128, QP = 2048, KVP = 1024;
constexpr float SCALE = 0.08838834764831845f, THR = 8.f;
constexpr int NW = 8, QBLK = 32, KVBLK = 64, QB = NW * QBLK;
constexpr int SHM_V = KVBLK * D * 2, SHM_K = KVBLK * D * 2;
constexpr int LDS_G = 2 * SHM_V + 2 * SHM_K + NW * 64 * 4;
constexpr int LDS_BYTES = LDS_G + 2 * 64 * 4;
#define KSWZ(row, colB) ((row) * 256 + ((colB) ^ (((row) & 7) << 4)))
#define SBAR() __builtin_amdgcn_sched_barrier(0)
__device__ __forceinline__ int v_st(int k, int c) { const int kk = (k & ~0xC) | ((k & 4) << 1) | ((k & 8) >> 1); return ((kk >> 3) * 4 + (c >> 5)) * 512 + ((kk & 7) * 32 + (c & 31)) * 2; }
__device__ __forceinline__ int v_rd_base(int lane) { return ((lane & 3) << 3) | (((lane >> 2) & 3) << 6) | (((lane >> 4) & 1) << 5) | (((lane >> 5) & 1) << 8); }
constexpr int v_rd_off(int d0, int ks, int half) { return d0 * 512 + ks * 4096 + half * 2048; }
__device__ __forceinline__ int crow(int r, int hi) { return (r & 3) + 8 * (r >> 2) + 4 * hi; }
__device__ __forceinline__ unsigned cvtpk_a(float lo, float hi) { unsigned r; asm volatile("v_cvt_pk_bf16_f32 %0, %1, %2" : "=v"(r) : "v"(lo), "v"(hi)); return r; }
__device__ __forceinline__ bf16x8 load8(const bf16_t* p) { return *reinterpret_cast<const bf16x8*>(p); }
__device__ __forceinline__ bf16x8 ldu(const void* ubase, unsigned off) { return *reinterpret_cast<const bf16x8*>((const char*)ubase + off); }
__device__ __forceinline__ void mask_tile(f32x16& p0, f32x16& p1, int dq) {
    const float NEG = -__builtin_inff();
#pragma unroll
    for (int r = 0; r < 16; ++r) { const int c = (r & 3) + 8 * (r >> 2); if (dq - c < 0) p0[r] = NEG; if (dq - c - 32 < 0) p1[r] = NEG; }
}
__device__ __forceinline__ void partialSM(f32x16& p0, f32x16& p1, float& m_reg, float& mn, float& alpha) {
    float pmax = p0[0];
#pragma unroll
    for (int r = 1; r < 16; ++r) pmax = fmaxf(pmax, p0[r]);
#pragma unroll
    for (int r = 0; r < 16; ++r) pmax = fmaxf(pmax, p1[r]);
    { auto rr = __builtin_amdgcn_permlane32_swap(__float_as_uint(pmax), __float_as_uint(pmax), false, false);
      pmax = fmaxf(__uint_as_float(rr[0]), __uint_as_float(rr[1])); }
    constexpr float C2 = 1.4426950408889634f * SCALE;
    if (__builtin_expect(__all((pmax - m_reg) * SCALE <= THR), 1)) { mn = m_reg; alpha = 1.f; }
    else { mn = fmaxf(m_reg, pmax); alpha = __builtin_amdgcn_exp2f((m_reg - mn) * C2); m_reg = mn; }
    const float mnL = -mn * C2;
#pragma unroll
    for (int r = 0; r < 16; ++r) p0[r] = fmaf(p0[r], C2, mnL);
#pragma unroll
    for (int r = 0; r < 16; ++r) p1[r] = fmaf(p1[r], C2, mnL);
#pragma unroll
    for (int r = 0; r < 16; ++r) p0[r] = __builtin_amdgcn_exp2f(p0[r]);
}
__device__ __forceinline__ void finishSM(f32x16& p0, f32x16& p1, float alpha, float& l_reg, bf16x8& pa0, bf16x8& pa1, bf16x8& pa2, bf16x8& pa3) {
#pragma unroll
    for (int r = 0; r < 16; ++r) p1[r] = __builtin_amdgcn_exp2f(p1[r]);
    float ps = 0;
#pragma unroll
    for (int r = 0; r < 16; ++r) ps += p0[r];
#pragma unroll
    for (int r = 0; r < 16; ++r) ps += p1[r];
    { auto rr = __builtin_amdgcn_permlane32_swap(__float_as_uint(ps), __float_as_uint(ps), false, false);
      ps = __uint_as_float(rr[0]) + __uint_as_float(rr[1]); }
    l_reg = l_reg * alpha + ps;
#define PK4(P, B_, OUT) do { unsigned a0 = cvtpk_a(P[B_+0], P[B_+1]), a1 = cvtpk_a(P[B_+2], P[B_+3]);                          \
        unsigned b0 = cvtpk_a(P[B_+4], P[B_+5]), b1 = cvtpk_a(P[B_+6], P[B_+7]);                                             \
        auto r0 = __builtin_amdgcn_permlane32_swap(a0, b0, false, false); auto r1 = __builtin_amdgcn_permlane32_swap(a1, b1, false, false); \
        u32x4 w = {r0[0], r1[0], r0[1], r1[1]}; OUT = *reinterpret_cast<bf16x8*>(&w); } while (0)
    PK4(p0, 0, pa0); PK4(p0, 8, pa1); PK4(p1, 0, pa2); PK4(p1, 8, pa3);
#undef PK4
}
template <int KB>
__device__ __forceinline__ void qkt(f32x16& p0, f32x16& p1, const char* K_lds, const char* G_lds, int r32, int hi, const bf16x8* qr) {
    const f32x4* gl = (const f32x4*)(G_lds + KB * 256 + hi * 16);
#pragma unroll
    for (int j = 0; j < 4; ++j) { const f32x4 a = gl[2 * j], b = gl[8 + 2 * j];
#pragma unroll
        for (int i = 0; i < 4; ++i) { p0[4 * j + i] = a[i]; p1[4 * j + i] = b[i]; } }
    const char* kb[4];
#pragma unroll
    for (int dd = 0; dd < 4; ++dd) kb[dd] = K_lds + KB * SHM_K + KSWZ(r32, (dd * 16 + hi * 8) * 2);
#pragma unroll
    for (int d0 = 0; d0 < 8; ++d0) { const char* a = kb[d0 & 3] + (d0 >> 2) * 128;
        bf16x8 b0 = *reinterpret_cast<const bf16x8*>(a);
        bf16x8 b1 = *reinterpret_cast<const bf16x8*>(a + 32 * 256);
        p0 = __builtin_amdgcn_mfma_f32_32x32x16_bf16(b0, qr[d0], p0, 0, 0, 0);
        p1 = __builtin_amdgcn_mfma_f32_32x32x16_bf16(b1, qr[d0], p1, 0, 0, 0); }
}
template <int VB>
__device__ __forceinline__ void pv_tile(f32x16* o, int vb0, bf16x8 pa0, bf16x8 pa1, bf16x8 pa2, bf16x8 pa3) {
#define TRRD(dst, off) asm volatile("ds_read_b64_tr_b16 %0, %1 offset:%2" : "=&v"(dst) : "v"(vb0), "i"(off) : "memory")
#define PV_D0(d0) do { s16x4 l0, l1, l2, l3, h0, h1, h2, h3; constexpr int b_ = VB * SHM_V + v_rd_off(d0, 0, 0); \
        TRRD(l0, b_); TRRD(h0, b_ + 2048); TRRD(l1, b_ + 4096); TRRD(h1, b_ + 6144); TRRD(l2, b_ + 8192); TRRD(h2, b_ + 10240); TRRD(l3, b_ + 12288); TRRD(h3, b_ + 14336); \
        asm volatile("s_waitcnt lgkmcnt(0)" ::: "memory"); SBAR();   \
        o[d0] = __builtin_amdgcn_mfma_f32_32x32x16_bf16(pa0, (bf16x8){l0[0], l0[1], l0[2], l0[3], h0[0], h0[1], h0[2], h0[3]}, o[d0], 0, 0, 0);   \
        o[d0] = __builtin_amdgcn_mfma_f32_32x32x16_bf16(pa1, (bf16x8){l1[0], l1[1], l1[2], l1[3], h1[0], h1[1], h1[2], h1[3]}, o[d0], 0, 0, 0);   \
        o[d0] = __builtin_amdgcn_mfma_f32_32x32x16_bf16(pa2, (bf16x8){l2[0], l2[1], l2[2], l2[3], h2[0], h2[1], h2[2], h2[3]}, o[d0], 0, 0, 0);   \
        o[d0] = __builtin_amdgcn_mfma_f32_32x32x16_bf16(pa3, (bf16x8){l3[0], l3[1], l3[2], l3[3], h3[0], h3[1], h3[2], h3[3]}, o[d0], 0, 0, 0); } while (0)
    PV_D0(0); PV_D0(1); PV_D0(2); PV_D0(3);
#undef PV_D0
#undef TRRD
}
struct BlockRef { const bf16_t* Q; const bf16_t* K; const bf16_t* V; bf16_t* O; const float* G; int P0; };
struct Seam { bf16x8 qr[8]; bf16x8 st_v0, st_v1, st_k0, st_k1; float g0, g1; };
#define ROW(p, k0, rr) ((p) + (size_t)((k0) + (rr)) * KVP + sc)
#define VMW() asm volatile("s_waitcnt vmcnt(0)" ::: "memory")
#define VMWN(n) asm volatile("s_waitcnt vmcnt(%0)" :: "i"(n) : "memory")
#define SLOAD_H(Kp, Vp, Gp, gqv, k0) do { const bf16_t* kt_ = (Kp) + (size_t)(k0) * KVP; const bf16_t* vt_ = (Vp) + (size_t)(k0) * KVP; const float* gt_ = (Gp) + (k0); \
                         S.st_v0 = ldu(vt_, loff); S.st_v1 = ldu(vt_ + 32 * KVP, loff); S.st_k0 = ldu(kt_, loff); S.st_k1 = ldu(kt_ + 32 * KVP, loff); \
                         S.g0 = (gqv) - *(const float*)((const char*)gt_ + goff); S.g1 = (gqv) - *(const float*)((const char*)(gt_ + 32) + goff); } while (0)
#define SWRITE_HK(bf) do { *(bf16x8*)(K_lds + (bf) * SHM_K + kws) = S.st_k0; *(bf16x8*)(K_lds + (bf) * SHM_K + kws + 32 * 256) = S.st_k1; \
                           if ((tid & 15) == 0) { ((float*)(G_lds + (bf) * 256))[sr] = S.g0; ((float*)(G_lds + (bf) * 256))[32 + sr] = S.g1; } } while (0)
#define SWRITE_HV(bf) do { *(bf16x8*)(V_lds + (bf) * SHM_V + vst0) = S.st_v0; *(bf16x8*)(V_lds + (bf) * SHM_V + vst1) = S.st_v1; } while (0)
#define SWRITE_H(bf) do { SWRITE_HV(bf); SWRITE_HK(bf); } while (0)
__device__ __forceinline__ void prime(const BlockRef& cur, char* lds, Seam& S) {
    int tid = threadIdx.x; asm volatile("" : "+v"(tid)); const int wid = __builtin_amdgcn_readfirstlane(tid >> 6), lane = tid & 63, r32 = lane & 31, hi = lane >> 5;
    const int sr = tid >> 4, sc = (tid & 15) * 8, kws = KSWZ(sr, sc * 2); char* K_lds = lds + 2 * SHM_V; char* G_lds = lds + LDS_G;
    const unsigned loff = (unsigned)(sr * KVP + sc) * 2u, goff = (unsigned)sr * 4u, qoff = (unsigned)(r32 * QP + hi * 8) * 2u;
    { const bf16_t* qb_ = cur.Q + (size_t)(wid * QBLK) * QP;
#pragma unroll
    for (int d0 = 0; d0 < 8; ++d0) S.qr[d0] = ldu(qb_ + d0 * 16, qoff); }
    SLOAD_H(cur.K, cur.V, cur.G, cur.G[cur.P0], 0); VMW(); SWRITE_HK(0);
    __syncthreads();
}
__device__ __forceinline__ void block(const BlockRef& cur, const BlockRef& nxt, char* lds, Seam& S) {
    int tid = threadIdx.x; asm volatile("" : "+v"(tid)); const int wid = __builtin_amdgcn_readfirstlane(tid >> 6), lane = tid & 63, r32 = lane & 31, hi = lane >> 5;
    const int NT = (cur.P0 + QB) / KVBLK;
    const int qlo = cur.P0 + wid * QBLK, qm = qlo + r32 - 4 * hi;
    char* V_lds = lds; char* K_lds = lds + 2 * SHM_V; char* G_lds = lds + LDS_G;
    float* ws = (float*)(lds + 2 * SHM_V + 2 * SHM_K) + wid * 64; float* li_l = ws, * al_l = ws + 32;
    float m_reg = -1e30f, l_reg = 0; f32x16 o[4] = {};
    const int sr = tid >> 4, sc = (tid & 15) * 8, vst0 = v_st(sr, sc), vst1 = v_st(32 + sr, sc), kws = KSWZ(sr, sc * 2);
    const unsigned loff = (unsigned)(sr * KVP + sc) * 2u, goff = (unsigned)sr * 4u, qoff = (unsigned)(r32 * QP + hi * 8) * 2u;
    const int vb0 = (int)(uintptr_t)V_lds + v_rd_base(lane);
    const bf16_t* Kh = cur.K; const bf16_t* Vh = cur.V; const float* Gh = cur.G;
    const float gq = Gh[cur.P0];
#define RESC(a) do { if (__any((a) < 1.f)) { if (hi == 0) al_l[r32] = (a); asm volatile("s_waitcnt lgkmcnt(0)" ::: "memory");              \
                     for (int d_ = 0; d_ < 4; ++d_) for (int r = 0; r < 16; ++r) o[d_][r] *= al_l[crow(r, hi)]; } } while (0)
#define KBASE(t) ((t) * KVBLK)
#define MASKT(P0_, P1_, t) do { const int kb_ = KBASE(t); if (kb_ + KVBLK - 1 > qlo) mask_tile(P0_, P1_, qm - kb_); } while (0)
    constexpr int NQL = 8;
#define SEAM_K0() do { VMWN(NQL); SWRITE_HK(0); SBAR(); } while (0)
    f32x16 pA0, pA1, pB0, pB1; float mnA, mnB, alA, alB; bf16x8 pa0, pa1, pa2, pa3;
    SWRITE_HV(0); SBAR();
    if (NT > 1) { SLOAD_H(Kh, Vh, Gh, gq, KBASE(1)); }
    SBAR(); qkt<0>(pA0, pA1, K_lds, G_lds, r32, hi, S.qr);
    MASKT(pA0, pA1, 0); partialSM(pA0, pA1, m_reg, mnA, alA);
    if (NT > 1) { VMW(); SWRITE_H(1); }
    __syncthreads();
#define HALF_STEP(PX0, PX1, mnX, alX, PY0, PY1, alY, t, KB, VB, SB) do {                                                      \
        SBAR(); qkt<KB>(PX0, PX1, K_lds, G_lds, r32, hi, S.qr);                                             \
        finishSM(PY0, PY1, alY, l_reg, pa0, pa1, pa2, pa3); SBAR();                                                           \
        if ((t) + 1 < NT) { SLOAD_H(Kh, Vh, Gh, gq, KBASE((t) + 1)); SBAR(); }                                               \
        pv_tile<VB>(o, vb0, pa0, pa1, pa2, pa3); MASKT(PX0, PX1, (t)); partialSM(PX0, PX1, m_reg, mnX, alX);                                        \
        __syncthreads();                                                                                                      \
        if ((t) + 1 < NT) { VMW(); SWRITE_H(SB); }                                                                          \
        RESC(alX); __syncthreads(); } while (0)
    for (int t = 1; t + 1 < NT; t += 2) {
        HALF_STEP(pB0, pB1, mnB, alB, pA0, pA1, alA, t, 1, 0, 0);
        HALF_STEP(pA0, pA1, mnA, alA, pB0, pB1, alB, t + 1, 0, 1, 1);
    }
    { SBAR(); qkt<1>(pB0, pB1, K_lds, G_lds, r32, hi, S.qr); SBAR(); }
    SLOAD_H(nxt.K, nxt.V, nxt.G, nxt.G[nxt.P0], 0); SBAR();
    { const bf16_t* qb_ = nxt.Q + (size_t)(wid * QBLK) * QP;
#pragma unroll
    for (int d0 = 0; d0 < 8; ++d0) S.qr[d0] = ldu(qb_ + d0 * 16, qoff); }
    SBAR();
    finishSM(pA0, pA1, alA, l_reg, pa0, pa1, pa2, pa3); SBAR();
    pv_tile<0>(o, vb0, pa0, pa1, pa2, pa3);
    { MASKT(pB0, pB1, NT - 1); partialSM(pB0, pB1, m_reg, mnB, alB); __syncthreads(); RESC(alB);
      finishSM(pB0, pB1, alB, l_reg, pa0, pa1, pa2, pa3); SBAR(); pv_tile<1>(o, vb0, pa0, pa1, pa2, pa3); }
    SBAR(); SEAM_K0();
    if (hi == 0) li_l[r32] = l_reg; asm volatile("s_waitcnt lgkmcnt(0)" ::: "memory");
    float rli[16];
#pragma unroll
    for (int r = 0; r < 16; ++r) rli[r] = __builtin_amdgcn_rcpf(li_l[crow(r, hi)]);
    bf16_t* Ow = cur.O + (size_t)(wid * QBLK) * QP;
    unsigned ooff = (unsigned)(4 * hi * QP + r32) * 2u; asm volatile("" : "+v"(ooff));
#pragma unroll
    for (int r = 0; r < 16; ++r) { char* orp = (char*)(Ow + (size_t)((r & 3) + 8 * (r >> 2)) * QP);
#pragma unroll
        for (int d0 = 0; d0 < 4; ++d0) { const float v = o[d0][r] * rli[r];
            const float vn = __shfl_xor(v, 1);
            if ((r32 & 1) == 0) *(unsigned*)(orp + ooff + d0 * 64) = cvtpk_a(v, vn); } }
    __syncthreads();
#undef RESC
#undef KBASE
#undef MASKT
#undef SEAM_K0
#undef HALF_STEP
}
#undef ROW
#undef VMW
#undef VMWN
#undef SLOAD_H
#undef SWRITE_HK
#undef SWRITE_HV
#undef SWRITE_H
#undef KSWZ
#undef SBAR
}

namespace ret {
constexpr int PQ = 272, PT = 144, PO = 528;
constexpr int L_Q = 0, L_K = 64 * PQ, L_KT = L_K + 64 * PQ, L_VT = L_KT + 128 * PT, L_P = L_VT + 256 * PT, L_O = L_P + 64 * PT, L_END = L_O + 64 * PO;
static_assert(L_END <= 140000, "retention LDS");
__device__ __forceinline__ int crow(int r, int hi) { return (r & 3) + 8 * (r >> 2) + 4 * hi; }
#define MF32(a, b, c) __builtin_amdgcn_mfma_f32_32x32x16_bf16((a), (b), (c), 0, 0, 0)
__device__ __forceinline__ bf16x8 ld16(const LAS unsigned char* p) { return *(const LAS bf16x8*)p; }
template <bool PH2, bool DRY = false>
__device__ __forceinline__ void unit(int bh, int g, const bf16_t* RQK, const bf16_t* RV, bf16_t* YB, float* GS, LAS unsigned char* lds, bf16_t* dummy = nullptr) {
    int tid = threadIdx.x; asm volatile("" : "+v"(tid)); const int w = __builtin_amdgcn_readfirstlane(tid >> 6), lane = tid & 63, r32 = lane & 31, hi = lane >> 5;
    const int b = bh >> 2, h = bh & 3;
    const float lg = log2f(1.0f - exp2f(-5.0f - (float)h));
    const float dchunk = exp2f(64.f * lg);
    f32x16 st[4];
#pragma unroll
    for (int db = 0; db < 4; ++db) st[db] = f32x16{};
    if (PH2) {
        const float dgrp = exp2f(512.f * lg);
        for (int gp = 0; gp < g; ++gp) { const float* src = GS + ((size_t)(bh * 16 + gp) * 128) * 256 + 32 * w + r32;
#pragma unroll
            for (int db = 0; db < 4; ++db)
#pragma unroll
                for (int r = 0; r < 16; ++r) st[db][r] = st[db][r] * dgrp + src[(size_t)(32 * db + crow(r, hi)) * 256]; }
    }
    const int sj = tid & 63, sc0 = tid >> 6;
    const int r32_0 = r32, hi_0 = hi, sj_0 = sj;
    for (int ci = 0; ci < 8; ++ci) {
        const size_t tok0 = (size_t)b * SEQ + (size_t)(g * 8 + ci) * 64;
        int r32 = r32_0, hi = hi_0, sj = sj_0; asm volatile("" : "+v"(r32), "+v"(hi), "+v"(sj));
        const float kdec = exp2f((64.f - (float)sj) * lg);
        {
            const bf16_t* rowp = RQK + (tok0 + sj) * 1024 + h * 128;
#pragma unroll
            for (int m = 0; m < 2; ++m) { const int c = sc0 + 8 * m;
                const u32x4 kv = *(const u32x4*)(rowp + 512 + c * 8);
                if (PH2) { const u32x4 qv = *(const u32x4*)(rowp + c * 8);
                    *(LAS u32x4*)(lds + L_Q + sj * PQ + c * 16) = qv; *(LAS u32x4*)(lds + L_K + sj * PQ + c * 16) = kv; }
                const unsigned kw[4] = {kv.x, kv.y, kv.z, kv.w};
#pragma unroll
                for (int q = 0; q < 4; ++q) { const unsigned pk = cvtpk(bflo(kw[q]) * kdec, bfhi(kw[q]) * kdec);
                    *(LAS unsigned short*)(lds + L_KT + (c * 8 + 2 * q) * PT + sj * 2) = (unsigned short)(pk & 0xffffu);
                    *(LAS unsigned short*)(lds + L_KT + (c * 8 + 2 * q + 1) * PT + sj * 2) = (unsigned short)(pk >> 16); } }
            const bf16_t* vrow = RV + (tok0 + sj) * 1024 + h * 256;
#pragma unroll
            for (int m = 0; m < 4; ++m) { const int c = sc0 + 8 * m; const u32x4 vv = *(const u32x4*)(vrow + c * 8);
                const unsigned vw[4] = {vv.x, vv.y, vv.z, vv.w};
#pragma unroll
                for (int q = 0; q < 4; ++q) {
                    *(LAS unsigned short*)(lds + L_VT + (c * 8 + 2 * q) * PT + sj * 2) = (unsigned short)(vw[q] & 0xffffu);
                    *(LAS unsigned short*)(lds + L_VT + (c * 8 + 2 * q + 1) * PT + sj * 2) = (unsigned short)(vw[q] >> 16); } }
        }
        __syncthreads();
        if (PH2) {
            if (w < 4) { const int ib = w >> 1, jb = w & 1; f32x16 s = f32x16{};
#pragma unroll
                for (int k0 = 0; k0 < 8; ++k0) s = MF32(ld16(lds + L_Q + (32 * ib + r32) * PQ + (k0 * 16 + 8 * hi) * 2), ld16(lds + L_K + (32 * jb + r32) * PQ + (k0 * 16 + 8 * hi) * 2), s);
                const int j = 32 * jb + r32;
#pragma unroll
                for (int r = 0; r < 16; ++r) { const int i = 32 * ib + crow(r, hi); const int dd = i > j ? i - j : j - i;
                    const float pv = s[r] * exp2f((float)dd * lg);
                    *(LAS unsigned short*)(lds + L_P + i * PT + j * 2) = (unsigned short)(cvtpk(pv, 0.f) & 0xffffu); } }
            __syncthreads();
            bf16x8 sb[4][2];
#pragma unroll
            for (int db = 0; db < 4; ++db)
#pragma unroll
                for (int kk = 0; kk < 2; ++kk) { u32x4 p; p.x = cvtpk(st[db][8 * kk + 0], st[db][8 * kk + 1]); p.y = cvtpk(st[db][8 * kk + 2], st[db][8 * kk + 3]);
                    p.z = cvtpk(st[db][8 * kk + 4], st[db][8 * kk + 5]); p.w = cvtpk(st[db][8 * kk + 6], st[db][8 * kk + 7]); sb[db][kk] = __builtin_bit_cast(bf16x8, p); }
#pragma unroll
            for (int ib = 0; ib < 2; ++ib) {
                f32x16 ao = f32x16{}, ai = f32x16{};
#pragma unroll
                for (int k0 = 0; k0 < 4; ++k0) ao = MF32(ld16(lds + L_P + (32 * ib + r32) * PT + (k0 * 16 + 8 * hi) * 2), ld16(lds + L_VT + (32 * w + r32) * PT + (k0 * 16 + 8 * hi) * 2), ao);
#pragma unroll
                for (int db = 0; db < 4; ++db)
#pragma unroll
                    for (int kk = 0; kk < 2; ++kk) { const LAS unsigned char* qp = lds + L_Q + (32 * ib + r32) * PQ + (32 * db + 16 * kk + 4 * hi) * 2;
                        const u32x2 lo = *(const LAS u32x2*)qp, hi2 = *(const LAS u32x2*)(qp + 16); u32x4 a; a.x = lo.x; a.y = lo.y; a.z = hi2.x; a.w = hi2.y;
                        ai = MF32(__builtin_bit_cast(bf16x8, a), sb[db][kk], ai); }
                __builtin_amdgcn_sched_barrier(0);
#pragma unroll
                for (int r = 0; r < 16; ++r) { const int i = 32 * ib + crow(r, hi); const float ov = ao[r] + exp2f((float)i * lg) * ai[r];
                    *(LAS unsigned short*)(lds + L_O + i * PO + (32 * w + r32) * 2) = (unsigned short)(cvtpk(ov, 0.f) & 0xffffu); }
                __builtin_amdgcn_sched_barrier(0);
            }
        }
#pragma unroll
        for (int db = 0; db < 4; ++db) { f32x16 s = st[db] * dchunk;
#pragma unroll
            for (int k0 = 0; k0 < 4; ++k0) s = MF32(ld16(lds + L_KT + (32 * db + r32) * PT + (k0 * 16 + 8 * hi) * 2), ld16(lds + L_VT + (32 * w + r32) * PT + (k0 * 16 + 8 * hi) * 2), s);
            st[db] = s; __builtin_amdgcn_sched_barrier(0); }
        __syncthreads();
        if (PH2) {
            int tid_o = tid; asm volatile("" : "+v"(tid_o)); const int i = tid_o >> 3, seg = tid_o & 7;
            const LAS unsigned char* op = lds + L_O + i * PO + seg * 64;
            float v[32]; float ss = 0.f;
#pragma unroll
            for (int q = 0; q < 4; ++q) { const u32x4 ow = *(const LAS u32x4*)(op + q * 16); const unsigned oo[4] = {ow.x, ow.y, ow.z, ow.w};
#pragma unroll
                for (int z = 0; z < 4; ++z) { v[q * 8 + 2 * z] = bflo(oo[z]); v[q * 8 + 2 * z + 1] = bfhi(oo[z]); } }
#pragma unroll
            for (int z = 0; z < 32; ++z) ss += v[z] * v[z];
            ss += __shfl_xor(ss, 1); ss += __shfl_xor(ss, 2); ss += __shfl_xor(ss, 4);
            const float rstd = 1.0f / sqrtf(ss * (1.0f / 256.0f) + EPS);
            bf16_t* yp = YB + (tok0 + i) * 2048 + h * 256 + seg * 32;
#pragma unroll
            for (int q = 0; q < 4; ++q) { const u32x4 gw = *(const u32x4*)(yp + q * 8); const unsigned gg[4] = {gw.x, gw.y, gw.z, gw.w}; u32x4 o;
                unsigned oo[4];
#pragma unroll
                for (int z = 0; z < 4; ++z) oo[z] = cvtpk(bflo(gg[z]) * v[q * 8 + 2 * z] * rstd, bfhi(gg[z]) * v[q * 8 + 2 * z + 1] * rstd);
                o.x = oo[0]; o.y = oo[1]; o.z = oo[2]; o.w = oo[3]; *(u32x4*)((DRY ? dummy + i * 2048 + seg * 32 : yp) + q * 8) = o; }
            __syncthreads();
        }
    }
    if (!PH2) { float* dst = GS + ((size_t)(bh * 16 + g) * 128) * 256 + 32 * w + r32;
#pragma unroll
        for (int db = 0; db < 4; ++db)
#pragma unroll
            for (int r = 0; r < 16; ++r) dst[(size_t)(32 * db + crow(r, hi)) * 256] = st[db][r]; }
}
#undef MF32
}


#define XB_TMO      128
#define XB_XCNT(j)  (256  + 64 * (j))
#define XB_XSUB(j)  (1280 + 64 * (j))
#define XB_XGEN(j)  (2304 + 64 * (j))
#define XB_TOP      3328
#define XB_TOPGEN   3392
#define XCD_BAR_WORDS 3456
#define XB_SPIN_CAP (1u << 18)
__device__ __forceinline__ unsigned xb_ld(unsigned* p)              { return __hip_atomic_load(p, __ATOMIC_RELAXED, __HIP_MEMORY_SCOPE_AGENT); }
__device__ __forceinline__ unsigned xb_add(unsigned* p, unsigned v) { return __hip_atomic_fetch_add(p, v, __ATOMIC_RELAXED, __HIP_MEMORY_SCOPE_AGENT); }
__device__ __forceinline__ unsigned xb_xcc_id() { return (unsigned)__builtin_amdgcn_s_getreg((3 << 11) | 20) & 0xFu; }
#define XB_SPIN(cond, bar) do { unsigned _sp = 0; while (cond) { __builtin_amdgcn_s_sleep(1); \
    if ((++_sp & 255u) == 0u) { if (xb_ld(&(bar)[XB_TMO])) break; if (_sp > XB_SPIN_CAP) { atomicAdd(&(bar)[XB_TMO], 1u); break; } } } } while (0)
struct XcdBarrier { unsigned* bar; unsigned x; volatile LAS unsigned* st; };
__device__ __forceinline__ XcdBarrier xcd_barrier_post(unsigned* bar, volatile LAS unsigned* st) {
    XcdBarrier b; b.bar = bar; b.x = xb_xcc_id(); b.st = st;
    if (threadIdx.x == 0) (void)xb_add(&bar[XB_XCNT(b.x)], 1u);
    return b;
}
__device__ __forceinline__ void xcd_barrier_complete(unsigned* bar, unsigned x, unsigned& nloc, unsigned& nx) {
    const unsigned G = gridDim.x * gridDim.y * gridDim.z;
    unsigned sum, cnt, mine, sp = 0u;
    for (;;) {
        sum = 0u; cnt = 0u; mine = 0u;
#pragma unroll
        for (unsigned j = 0; j < 16; ++j) { const unsigned c = xb_ld(&bar[XB_XCNT(j)]); sum += c; cnt += (c > 0u) ? 1u : 0u; mine = (j == x) ? c : mine; }
        if (sum == G) break;
        __builtin_amdgcn_s_sleep(1);
        if ((++sp & 255u) == 0u) { if (xb_ld(&bar[XB_TMO])) break; if (sp > XB_SPIN_CAP) { atomicAdd(&bar[XB_TMO], 1u); break; } }
    }
    nloc = mine > 0u ? mine : 1u; nx = cnt > 0u ? cnt : 1u;
}
__device__ __forceinline__ void xcd_barrier(const XcdBarrier& b) {
    asm volatile("s_waitcnt vmcnt(0)" ::: "memory");
    __syncthreads();
    if (threadIdx.x == 0) {
        unsigned* bar = b.bar;
        __builtin_amdgcn_s_waitcnt(0);
        unsigned nloc = b.st[0], nx = b.st[1];
        if (nloc == 0u) { xcd_barrier_complete(bar, b.x, nloc, nx); b.st[0] = nloc; b.st[1] = nx; }
        const unsigned old = xb_add(&bar[XB_XSUB(b.x)], 1u);
        const unsigned gen = old / nloc;
        if (old + 1u == (gen + 1u) * nloc) {
            __builtin_amdgcn_fence(__ATOMIC_RELEASE, "agent");
            asm volatile("s_waitcnt vmcnt(0)" ::: "memory");
            const unsigned og = xb_add(&bar[XB_TOP], 1u);
            const unsigned tg = og / nx;
            if (og + 1u == (tg + 1u) * nx) xb_add(&bar[XB_TOPGEN], 1u);
            else XB_SPIN(xb_ld(&bar[XB_TOPGEN]) == tg, bar);
            __builtin_amdgcn_fence(__ATOMIC_ACQUIRE, "agent");
            xb_add(&bar[XB_XGEN(b.x)], 1u);
            asm volatile("s_waitcnt vmcnt(0)" ::: "memory");
        } else {
            XB_SPIN(xb_ld(&bar[XB_XGEN(b.x)]) == gen, bar);
            __builtin_amdgcn_fence(__ATOMIC_ACQUIRE, "agent");
            asm volatile("s_waitcnt vmcnt(0)" ::: "memory");
        }
    }
    __syncthreads();
}

__device__ __forceinline__ void transpose_item(const float* colp, int ldw, int k0, bf16_t* WT, size_t ldt, int n0, LAS float* scr, int lane) {
#pragma unroll 8
    for (int i = 0; i < 32; ++i) { const int kk = 2 * i + (lane >> 5); scr[kk * 33 + (lane & 31)] = colp[(size_t)(k0 + kk) * ldw]; }
    LDS_WAIT(); asm volatile("" ::: "memory");
    const int c = lane & 7;
#pragma unroll
    for (int j = 0; j < 4; ++j) { const int n = (lane >> 3) + 8 * j; const LAS float* s = scr + (8 * c) * 33 + n;
        u32x4 o; o.x = cvtpk(s[0 * 33], s[1 * 33]); o.y = cvtpk(s[2 * 33], s[3 * 33]); o.z = cvtpk(s[4 * 33], s[5 * 33]); o.w = cvtpk(s[6 * 33], s[7 * 33]);
        *(u32x4*)(WT + (size_t)(n0 + n) * ldt + k0 + 8 * c) = o; }
    LDS_WAIT(); asm volatile("" ::: "memory");
}
__device__ __forceinline__ int in_srccol(int j) {
    if (j < 1024) { const int jj = j & 127; return (j & ~127) + (jj & 1) * 64 + (jj >> 1); }
    if (j < 6144) return j;
    return j + 8;
}
template <bool SILU>
__device__ __forceinline__ void gemv_item(const float* W, int ldw, int col0, const float* v0, const float* v1, const float* bias, float* out0, float* out1, int ostride, LAS float* red) {
    const int tid = threadIdx.x, w = tid >> 6, lane = tid & 63;
    float a0 = 0.f, a1 = 0.f; const float* wp = W + (size_t)(128 * w) * ldw + col0 + lane;
#pragma unroll 8
    for (int k = 0; k < 128; ++k) { float x0 = v0[128 * w + k], x1 = v1[128 * w + k]; if (SILU) { x0 = siluf_(x0); x1 = siluf_(x1); }
        const float wv = wp[(size_t)k * ldw]; a0 += x0 * wv; a1 += x1 * wv; }
    red[(w * 2 + 0) * 64 + lane] = a0; red[(w * 2 + 1) * 64 + lane] = a1;
    __syncthreads();
    if (w == 0) { float s0 = bias ? bias[col0 + lane] : 0.f, s1 = s0;
#pragma unroll
        for (int q = 0; q < 8; ++q) { s0 += red[(q * 2) * 64 + lane]; s1 += red[(q * 2 + 1) * 64 + lane]; }
        out0[(size_t)lane * ostride] = s0; out1[(size_t)lane * ostride] = s1; }
    __syncthreads();
}

struct Args { const float *x, *c, *ada_w, *ada_b, *norm1_w, *w_in, *b_f, *ret_proj, *fox_proj, *w_out, *norm2_w, *w_gate, *w_up, *w_down, *norm_f_w; float* out; unsigned char* ws; };

__global__ void __launch_bounds__(512) mega_fwd(Args a) {
    extern __shared__ __attribute__((aligned(16))) unsigned char lds_raw[];
    cg::grid_group grid = cg::this_grid();
    LAS unsigned char* lds = (LAS unsigned char*)lds_raw;
    const int tid = threadIdx.x, lane = tid & 63, wave = __builtin_amdgcn_readfirstlane(tid >> 6);
    const int G = gridDim.x, bx = blockIdx.x;
    const int vcu = (G % 8 == 0) ? (bx % 8) * (G / 8) + bx / 8 : bx;
    const int gw = vcu * 8 + wave, NGW = G * 8;
    unsigned char* ws = a.ws;
    float* MOD = (float*)(ws + WS_MOD); float* BIAS2 = (float*)(ws + WS_BIAS2); float* LOGF = (float*)(ws + WS_LOGF); float* GC = (float*)(ws + WS_G);
    bf16_t* WIN_T = (bf16_t*)(ws + WS_WIN); bf16_t* PROJ_T = (bf16_t*)(ws + WS_PROJ); bf16_t* WOUT_T = (bf16_t*)(ws + WS_WOUT); bf16_t* WDOWN_T = (bf16_t*)(ws + WS_WDOWN);
    float* SSQ = (float*)(ws + WS_SSQ); bf16_t* HB = (bf16_t*)(ws + WS_H); float* GS = (float*)(ws + WS_H); bf16_t* RQK = (bf16_t*)(ws + WS_RQK); bf16_t* RV = (bf16_t*)(ws + WS_RV);
    bf16_t* YB = (bf16_t*)(ws + WS_YB); bf16_t* FK = (bf16_t*)(ws + WS_FK); bf16_t* FV = (bf16_t*)(ws + WS_FV); bf16_t* GRF = (bf16_t*)a.out;
    bf16_t* MERGED = (bf16_t*)(ws + WS_H); bf16_t* A2 = (bf16_t*)(ws + WS_RQK); bf16_t* ACT = (bf16_t*)(ws + WS_RV); bf16_t* GU_T = (bf16_t*)(ws + WS_WIN);
    { volatile LAS unsigned* misc = (volatile LAS unsigned*)(lds + LDS_BYTES - 256); if (tid < 8) misc[tid] = 0u; }
    __syncthreads();
    XcdBarrier xbar = xcd_barrier_post((unsigned*)(ws + WS_BAR), (volatile LAS unsigned*)(lds + LDS_BYTES - 256));
    if (a.ws == nullptr) grid.sync();
#define GSYNC() xcd_barrier(xbar)

#ifndef NO_P0
    REPEAT(PROBE_A) {
        for (int it = bx; it < 96; it += G) gemv_item<true>(a.ada_w, 6144, it * 64, a.c, a.c + 1024, a.ada_b, MOD + it * 64, MOD + 6144 + it * 64, 1, (LAS float*)lds);
        __syncthreads();
        LAS float* scr = (LAS float*)(lds + wave * 16384);
        constexpr int I_IN = 16 * 256, I_P = 16 * 32, I_DN = 44 * 32, NITEMS = I_IN + 3 * I_P + I_DN;
        for (int it = gw; it < NITEMS; it += NGW) {
            int r = it;
            if (r < I_IN) { const int kb = r / 256, nb = r % 256; transpose_item(a.w_in + in_srccol(nb * 32 + (lane & 31)), DINW, kb * 64, WIN_T, 1024, nb * 32, scr, lane); continue; } r -= I_IN;
            if (r < I_P) { const int kb = r / 32, nb = r % 32; transpose_item(a.ret_proj + nb * 32 + (lane & 31), 1024, kb * 64, PROJ_T, 2048, nb * 32, scr, lane); continue; } r -= I_P;
            if (r < I_P) { const int kb = r / 32, nb = r % 32; transpose_item(a.fox_proj + nb * 32 + (lane & 31), 1024, kb * 64, PROJ_T + 1024, 2048, nb * 32, scr, lane); continue; } r -= I_P;
            if (r < I_P) { const int kb = r / 32, nb = r % 32; transpose_item(a.w_out + nb * 32 + (lane & 31), 1024, kb * 64, WOUT_T, 1024, nb * 32, scr, lane); continue; } r -= I_P;
            { const int kb = r / 32, nb = r % 32; transpose_item(a.w_down + nb * 32 + (lane & 31), 1024, kb * 64, WDOWN_T, DFF, nb * 32, scr, lane); }
        }
    }
#endif
    GSYNC();
#ifndef NO_P1
    REPEAT(PROBE_A) {
        for (int it = bx; it < 88; it += G) { const int s = it >= 44, cb = (it - 44 * s) * 64;
            gemv_item<false>(s ? a.w_up : a.w_gate, DFF, cb, MOD + 3072, MOD + 6144 + 3072, nullptr, BIAS2 + 2 * cb + s, BIAS2 + NGU + 2 * cb + s, 2, (LAS float*)lds); }
        int lane1 = lane; asm volatile("" : "+v"(lane1));
        float wff[16][8];
#pragma unroll
        for (int j = 0; j < 4; ++j)
#pragma unroll
            for (int q = 0; q < 4; ++q) { const float* p = a.w_in + (size_t)(4 * lane1 + 256 * j + q) * DINW + 6144; const f32x4 w0 = *(const f32x4*)p, w1 = *(const f32x4*)(p + 4);
                wff[4 * j + q][0] = w0[0]; wff[4 * j + q][1] = w0[1]; wff[4 * j + q][2] = w0[2]; wff[4 * j + q][3] = w0[3]; wff[4 * j + q][4] = w1[0]; wff[4 * j + q][5] = w1[1]; wff[4 * j + q][6] = w1[2]; wff[4 * j + q][7] = w1[3]; }
        const float bfl = a.b_f[lane1 & 7];
        for (int m = gw; m < MTOK; m += NGW) {
            const int b = m >> 13; const float* mod = MOD + b * 6144;
            const f32x4* xr = (const f32x4*)(a.x + (size_t)m * DM) + lane1;
            f32x4 v[4]; float s = 0.f;
#pragma unroll
            for (int j = 0; j < 4; ++j) { v[j] = xr[64 * j]; s += (v[j][0] * v[j][0] + v[j][1] * v[j][1]) + (v[j][2] * v[j][2] + v[j][3] * v[j][3]); }
            const float rstd = 1.0f / sqrtf(wave_sum(s) * (1.0f / DM) + EPS);
            float p8[8] = {0.f, 0.f, 0.f, 0.f, 0.f, 0.f, 0.f, 0.f};
            unsigned long long* o8 = (unsigned long long*)(HB + (size_t)m * DM) + lane1;
#pragma unroll
            for (int j = 0; j < 4; ++j) { const int col = 4 * lane1 + 256 * j;
                const f32x4 nw = *(const f32x4*)(a.norm1_w + col), sh = *(const f32x4*)(mod + col), sc = *(const f32x4*)(mod + 1024 + col);
                const f32x4 hv = (v[j] * rstd * nw) * (sc + 1.0f) + sh;
                o8[64 * j] = (unsigned long long)cvtpk(hv[0], hv[1]) | ((unsigned long long)cvtpk(hv[2], hv[3]) << 32);
#pragma unroll
                for (int q = 0; q < 4; ++q)
#pragma unroll
                    for (int hh = 0; hh < 8; ++hh) p8[hh] += hv[q] * wff[4 * j + q][hh]; }
#pragma unroll
            for (int hh = 0; hh < 8; ++hh) p8[hh] = wave_sum(p8[hh]);
            float mine = p8[0];
#pragma unroll
            for (int hh = 1; hh < 8; ++hh) mine = (lane1 & 7) == hh ? p8[hh] : mine;
            if (lane1 < 8) { const float z = mine + bfl; LOGF[(size_t)m * 8 + lane1] = fminf(z, 0.f) - log1pf(__expf(-fabsf(z))); }
        }
    }
#endif
    GSYNC();
#ifndef NO_P2
    REPEAT(PROBE_G) {
        if (bx < 16) {
            const int b = bx >> 3, hh = bx & 7; const int s0 = tid * 16; float vals[16]; double tot = 0.0;
#pragma unroll
            for (int i = 0; i < 16; ++i) { vals[i] = LOGF[((size_t)b * SEQ + s0 + i) * 8 + hh]; tot += (double)vals[i]; }
            double incl = tot;
#pragma unroll
            for (int o = 1; o < 64; o <<= 1) { const double t2 = __shfl_up(incl, o); if (lane >= o) incl += t2; }
            LAS double* wsum = (LAS double*)lds;
            if (lane == 63) wsum[wave] = incl;
            __syncthreads();
            double run = incl - tot;
            for (int q = 0; q < wave; ++q) run += wsum[q];
#pragma unroll
            for (int i = 0; i < 16; ++i) { run += (double)vals[i]; GC[(size_t)bx * SEQ + s0 + i] = (float)(run * 11.313708498984761); }
            __syncthreads();
        }
        pg8::Gemm g{HB, WIN_T, MTOK, NIN, DM}; pg8::StaticOrder S; S.init(MTOK, NIN, G, bx);
        EpiIn E{RQK, RV, YB, FK, FV, GRF};
        pg8::gemm_phase<EpiIn, pg8::StaticOrder>(lds, g, S, E);
    }
#endif
    GSYNC();
#ifndef NO_P3A
    REPEAT(PROBE_A) {
        LAS float* scr = (LAS float*)(lds + wave * 16384);
        for (int it = gw; it < 16 * 176; it += NGW) { const int kb = it / 176, nb = it % 176; const int np = nb * 32 + (lane & 31);
            transpose_item(((np & 1) ? a.w_up : a.w_gate) + (np >> 1), DFF, kb * 64, GU_T, 1024, nb * 32, scr, lane); }
        __syncthreads();
        for (int u = bx; u < 120; u += G) { const int bh = u / 15, g = u % 15; ret::unit<false>(bh, g, RQK, RV, YB, GS, lds); }
    }
#endif
    GSYNC();
#ifndef NO_P3B
    {
#ifndef NO_RET2
        if (PROBE_R) { for (int u = bx; u < 128; u += G) ret::unit<true, true>(u >> 4, u & 15, RQK, RV, YB, GS, lds, (bf16_t*)(ws + 48 * MiB)); __syncthreads(); }
        for (int u = bx; u < 128; u += G) ret::unit<true>(u >> 4, u & 15, RQK, RV, YB, GS, lds);
        __syncthreads();
#endif
#ifndef NO_ATT
        char* alds = (char*)lds_raw;
        for (int dry = PROBE_T ? 1 : 0; dry >= 0; --dry) if (vcu < 256) {
            int L = vcu, pass = 0;
#define FOX_REF(R, L_, pass_) do { const int bh_ = (L_) >> 4, x_ = (L_) & 15, b_ = bh_ >> 3, h_ = bh_ & 7, qb_ = (pass_) ? 31 - x_ : x_; \
                (R).K = FK + (size_t)b_ * SEQ * 1024 + h_ * 128; (R).V = FV + (size_t)b_ * SEQ * 1024 + h_ * 128; (R).G = GC + (size_t)bh_ * SEQ; \
                (R).Q = YB + ((size_t)b_ * SEQ + (size_t)qb_ * 256) * 2048 + 1024 + h_ * 128; (R).O = dry ? (bf16_t*)(ws + 48 * MiB) : const_cast<bf16_t*>((R).Q); (R).P0 = qb_ * 256; } while (0)
            fox::BlockRef cur; FOX_REF(cur, L, 0);
            fox::Seam S;
            fox::prime(cur, alds, S);
            for (;;) {
                const bool more_pass = pass == 0, more_item = L + G < 256, last = !more_pass && !more_item;
                int Ln = L, passn = pass + 1; if (!more_pass) { passn = 0; Ln = more_item ? L + G : L; }
                fox::BlockRef nxt = cur; if (!last) FOX_REF(nxt, Ln, passn);
                fox::block(cur, nxt, alds, S);
                if (last) break;
                cur = nxt; L = Ln; pass = passn;
            }
#undef FOX_REF
            asm volatile("s_waitcnt vmcnt(0)" ::: "memory");
            __syncthreads();
        }
#endif
    }
#endif
    GSYNC();
#ifndef NO_P4
    REPEAT(PROBE_F) {
        pg8::Gemm g{YB, PROJ_T, MTOK, DM, 2048}; pg8::StaticOrder S; S.init(MTOK, DM, G, bx);
        EpiMerge E{GRF, MERGED};
        pg8::gemm_phase<EpiMerge, pg8::StaticOrder>(lds, g, S, E);
    }
#endif
    GSYNC();
#ifndef NO_P5
    REPEAT(PROBE_F) {
        pg8::Gemm g{MERGED, WOUT_T, MTOK, DM, DM}; pg8::StaticOrder S; S.init(MTOK, DM, G, bx);
        EpiWout E{a.x, MOD, a.norm2_w, a.out, A2, SSQ};
        pg8::gemm_phase<EpiWout, pg8::StaticOrder>(lds, g, S, E);
    }
#endif
    GSYNC();
#ifndef NO_P6
    REPEAT(PROBE_F) {
        pg8::Gemm g{A2, GU_T, MTOK, NGU, DM}; pg8::StaticOrder S; S.init(MTOK, NGU, G, bx);
        EpiGU E{SSQ, BIAS2, ACT};
        pg8::gemm_phase<EpiGU, pg8::StaticOrder>(lds, g, S, E);
    }
#endif
    GSYNC();
#ifndef NO_P7
    {
        pg8::Gemm g{ACT, WDOWN_T, MTOK, DM, DFF}; pg8::StaticOrder S; S.init(MTOK, DM, G, bx);
        if (PROBE_D) { EpiDown E0{MOD, a.out, (float*)(ws + 32 * MiB)}; pg8::gemm_phase<EpiDown, pg8::StaticOrder>(lds, g, S, E0); }
        EpiDown E{MOD, a.out, a.out};
        pg8::gemm_phase<EpiDown, pg8::StaticOrder>(lds, g, S, E);
    }
#endif
    GSYNC();
#ifndef NO_P8
    {
        int lane8 = lane; asm volatile("" : "+v"(lane8));
        for (int m = gw; m < MTOK; m += NGW) {
            f32x4* xr = (f32x4*)(a.out + (size_t)m * DM) + lane8;
            f32x4 v[4]; float s = 0.f;
#pragma unroll
            for (int j = 0; j < 4; ++j) { v[j] = xr[64 * j]; s += (v[j][0] * v[j][0] + v[j][1] * v[j][1]) + (v[j][2] * v[j][2] + v[j][3] * v[j][3]); }
            const float rstd = 1.0f / sqrtf(wave_sum(s) * (1.0f / DM) + EPS);
#pragma unroll
            for (int j = 0; j < 4; ++j) { const f32x4 nw = *(const f32x4*)(a.norm_f_w + 4 * lane8 + 256 * j); xr[64 * j] = v[j] * rstd * nw; }
        }
    }
#endif
    if (PROBE_S) { for (int q = 0; q < 9; ++q) GSYNC(); }
}

extern "C" void kernel_launch(void* const* d_in, const int* in_sizes, int n_in, void* d_out, int out_size, void* d_ws, size_t ws_size, hipStream_t stream) {
    static int grid = 0;
    if (grid == 0) {
        if (n_in != 15 || out_size != MTOK * DM || ws_size < WS_END) { fprintf(stderr, "kernel_launch: unexpected shapes (n_in %d out %d ws %zu)\n", n_in, out_size, ws_size); grid = -1; return; }
        int dev = 0, cus = 0, per_cu = 0;
        (void)hipGetDevice(&dev); (void)hipDeviceGetAttribute(&cus, hipDeviceAttributeMultiprocessorCount, dev);
        (void)hipFuncSetAttribute((const void*)mega_fwd, hipFuncAttributeMaxDynamicSharedMemorySize, LDS_BYTES);
        if (hipOccupancyMaxActiveBlocksPerMultiprocessor(&per_cu, (const void*)mega_fwd, 512, LDS_BYTES) != hipSuccess || per_cu < 1) { fprintf(stderr, "kernel_launch: occupancy query failed\n"); per_cu = 1; }
        (void)hipGetLastError();
        if (per_cu > 1) per_cu = 1;
        grid = cus * per_cu;
    }
    if (grid < 0) return;
    (void)hipMemsetAsync((char*)d_ws + WS_BAR, 0, 16384, stream);
    Args a{};
    a.x = (const float*)d_in[0]; a.c = (const float*)d_in[1]; a.ada_w = (const float*)d_in[2]; a.ada_b = (const float*)d_in[3]; a.norm1_w = (const float*)d_in[4];
    a.w_in = (const float*)d_in[5]; a.b_f = (const float*)d_in[6]; a.ret_proj = (const float*)d_in[7]; a.fox_proj = (const float*)d_in[8]; a.w_out = (const float*)d_in[9];
    a.norm2_w = (const float*)d_in[10]; a.w_gate = (const float*)d_in[11]; a.w_up = (const float*)d_in[12]; a.w_down = (const float*)d_in[13]; a.norm_f_w = (const float*)d_in[14];
    a.out = (float*)d_out; a.ws = (unsigned char*)d_ws;
    void* args[] = {&a};
    hipError_t e = hipLaunchCooperativeKernel((const void*)mega_fwd, dim3(grid), dim3(512), args, LDS_BYTES, stream);
    if (e != hipSuccess) fprintf(stderr, "kernel_launch: cooperative launch failed: %s (grid %d)\n", hipGetErrorString(e), grid);
}
```

```cpp
#include <hip/hip_runtime.h>
#include <hip/hip_cooperative_groups.h>
#include <hip/hip_bf16.h>
#include <cstdio>
#include <cstdint>
namespace cg = cooperative_groups;
#ifndef PROBE_A
#define PROBE_A 0
#endif
#ifndef PROBE_G
#define PROBE_G 0
#endif
#ifndef PROBE_R
#define PROBE_R 0
#endif
#ifndef PROBE_T
#define PROBE_T 0
#endif
#ifndef PROBE_D
#define PROBE_D 0
#endif
#ifndef PROBE_S
#define PROBE_S 0
#endif
#ifndef PROBE_F
#define PROBE_F 0
#endif
#define REPEAT(flag) for (int rep_ = 0; rep_ < ((flag) ? 2 : 1); ++rep_)

#define LAS __attribute__((address_space(3)))
typedef unsigned short bf16_t;
typedef short bf16x8 __attribute__((ext_vector_type(8)));
typedef short s16x4 __attribute__((ext_vector_type(4)));
typedef float f32x2 __attribute__((ext_vector_type(2)));
typedef float f32x4 __attribute__((ext_vector_type(4)));
typedef float f32x16 __attribute__((ext_vector_type(16)));
typedef unsigned u32x2 __attribute__((ext_vector_type(2)));
typedef unsigned u32x4 __attribute__((ext_vector_type(4)));
typedef __bf16 bf16x2_t __attribute__((ext_vector_type(2)));

constexpr int SEQ = 8192, DM = 1024, MTOK = 2 * SEQ, DFF = 2816, NGU = 2 * DFF, DINW = 8200, NIN = 8192;
constexpr float EPS = 1e-6f;
constexpr size_t MiB = 1u << 20;
constexpr size_t WS_MOD = 0;
constexpr size_t WS_BIAS2 = 64 * 1024;
constexpr size_t WS_LOGF = 128 * 1024;
constexpr size_t WS_G = 640 * 1024;
constexpr size_t WS_BAR = 1536 * 1024;
constexpr size_t WS_WIN = 2 * MiB;
constexpr size_t WS_PROJ = 18 * MiB;
constexpr size_t WS_WOUT = 22 * MiB;
constexpr size_t WS_WDOWN = 24 * MiB;
constexpr size_t WS_SSQ = 30 * MiB;
constexpr size_t WS_H = 32 * MiB;
constexpr size_t WS_RQK = 64 * MiB;
constexpr size_t WS_RV = 96 * MiB;
constexpr size_t WS_YB = 128 * MiB;
constexpr size_t WS_FK = 192 * MiB;
constexpr size_t WS_FV = 224 * MiB;
constexpr size_t WS_END = 256 * MiB;
constexpr int LDS_BYTES = 147456;

__device__ __forceinline__ unsigned cvtpk(float lo, float hi) { f32x2 v = {lo, hi}; bf16x2_t b = __builtin_convertvector(v, bf16x2_t); return __builtin_bit_cast(unsigned, b); }
__device__ __forceinline__ float bf2f(unsigned short b) { return __uint_as_float((unsigned)b << 16); }
__device__ __forceinline__ float bflo(unsigned w) { return __uint_as_float(w << 16); }
__device__ __forceinline__ float bfhi(unsigned w) { return __uint_as_float(w & 0xffff0000u); }
__device__ __forceinline__ float sigmoidf_(float x) { return 1.f / (1.f + __expf(-x)); }
__device__ __forceinline__ float siluf_(float x) { return x / (1.f + __expf(-x)); }
__device__ __forceinline__ float wave_sum(float v) {
#pragma unroll
    for (int o = 1; o < 64; o <<= 1) v += __shfl_xor(v, o);
    return v;
}
#define LDS_WAIT() asm volatile("s_waitcnt lgkmcnt(0)" ::: "memory")

namespace pg8 {
#define PG8_LAS __attribute__((address_space(3)))
constexpr int BM = 256, BK = 64, HALF = 128, HTB = HALF * BK * 2, STAGE_BYTES = 8 * HTB, NXCD = 8, WGM = 8;
__host__ __device__ __forceinline__ int lds_byte(int r, int c) { const int st = (r >> 4) * 2 + (c >> 5), rr = r & 15, cc = c & 31, ob = rr * 64 + cc * 2; return st * 1024 + (ob ^ (((ob >> 9) & 1) << 5)); }
__host__ __device__ __forceinline__ void stage_rc(int b, int& R, int& C) { const int st = b / 1024, sb = b % 1024, swz = sb ^ (((sb >> 9) & 1) << 5); R = (st >> 1) * 16 + swz / 64; C = (st & 1) * 32 + (swz % 64) / 2; }
__host__ __device__ __forceinline__ int perm32(int rho) { const int n = rho >> 4, i = rho & 15; return 8 * (i >> 2) + 4 * n + (i & 3); }
struct Unit { int pm, pn; };
struct Gemm { const bf16_t* A; const bf16_t* Bt; int M, N, K; };
struct StaticOrder {
    int nM, nN, nwg, G, c;
    __host__ __device__ void init(int M, int N, int G_, int c_) { nM = M / BM; nN = N / BM; nwg = nM * nN; G = G_; c = c_; }
    __host__ __device__ bool next(int i, Unit& u) const {
        const long L = (long)i * G + c; if (L >= nwg) return false;
        int wgid = (int)L; { const int q = nwg / NXCD, r = nwg % NXCD, xcd = wgid % NXCD, off = wgid / NXCD; wgid = (xcd < r ? xcd * (q + 1) : r * (q + 1) + (xcd - r) * q) + off; }
        const int nig = WGM * nN, gid = wgid / nig, fm = gid * WGM, gsz = (nM - fm) < WGM ? (nM - fm) : WGM;
        u.pm = fm + ((wgid % nig) % gsz); u.pn = (wgid % nig) / gsz; return true;
    }
};
template <class Epi, class Sched>
__device__ __forceinline__ void gemm_phase(PG8_LAS unsigned char* lds, const Gemm g, const Sched& S, const Epi& E) {
    int tid = threadIdx.x; asm volatile("" : "+v"(tid));
    const int wid = __builtin_amdgcn_readfirstlane(tid >> 6), lane = tid & 63, wr = wid >> 2, wc = wid & 3; int fr = lane & 15, fq = lane >> 4;
    const int K = g.K, nt = K / BK;
    unsigned voffA[2], voffB[2];
#pragma unroll
    for (int i = 0; i < 2; ++i) { int R, C; stage_rc(tid * 16 + i * 8192, R, C); const int Rb = (R & ~31) + perm32(R & 31);
        voffA[i] = (unsigned)(R * K + C) * 2u; voffB[i] = (unsigned)(Rb * K + C) * 2u; }
    const size_t kstep = (size_t)(BK * 2);
    const size_t hstep = (size_t)HALF * K * 2;
    const size_t tstep = 2 * hstep;
    const unsigned ldsw = (unsigned)wid * 1024u;
    const int aoff = lds_byte(wr * 64 + fr, fq * 8), boff = lds_byte(wc * 32 + fr, fq * 8);
#define PG8_SA(b, h) (((b) * 2 + (h)) * HTB)
#define PG8_SB(b, h) ((4 + (b) * 2 + (h)) * HTB)
#define PG8_STAGE(bufoff, gbase, voff) do { _Pragma("unroll") for (int _i = 0; _i < 2; ++_i) \
        __builtin_amdgcn_global_load_lds((const unsigned*)((const char*)(gbase) + (voff)[_i]), (PG8_LAS unsigned*)(lds + (bufoff) + ldsw + _i * 8192), 16, 0, 0); } while (0)
#define PG8_LDA(dst, b, h) do { _Pragma("unroll") for (int m = 0; m < 4; ++m) _Pragma("unroll") for (int k = 0; k < 2; ++k) dst[m][k] = *(const PG8_LAS bf16x8*)(lds + PG8_SA(b, h) + aoff + m * 2048 + k * 1024); } while (0)
#define PG8_LDB(dst, b, h) do { _Pragma("unroll") for (int n = 0; n < 2; ++n) _Pragma("unroll") for (int k = 0; k < 2; ++k) dst[n][k] = *(const PG8_LAS bf16x8*)(lds + PG8_SB(b, h) + boff + n * 2048 + k * 1024); } while (0)
#define PG8_MMA(ai, bj, At, Bt) do { __builtin_amdgcn_s_setprio(1); _Pragma("unroll") for (int m = 0; m < 4; ++m) _Pragma("unroll") for (int n = 0; n < 2; ++n) _Pragma("unroll") for (int k = 0; k < 2; ++k) \
        acc[ai][bj][m][n] = __builtin_amdgcn_mfma_f32_16x16x32_bf16(Bt[n][k], At[m][k], acc[ai][bj][m][n], 0, 0, 0); __builtin_amdgcn_s_setprio(0); } while (0)
#define PG8_WAIT_V(n) asm volatile("s_waitcnt vmcnt(" #n ")" ::: "memory")
#define PG8_WAIT_L(n) asm volatile("s_waitcnt lgkmcnt(" #n ")" ::: "memory")
#define PG8_BAR __builtin_amdgcn_s_barrier()
#define PG8_SCHED __builtin_amdgcn_sched_barrier(0)
    Unit cur, nxt; int ui = 0;
    if (!S.next(0, cur)) return;
    f32x4 acc[2][2][4][2];
#pragma unroll
    for (int a = 0; a < 2; ++a)
#pragma unroll
        for (int b = 0; b < 2; ++b)
#pragma unroll
            for (int m = 0; m < 4; ++m)
#pragma unroll
                for (int n = 0; n < 2; ++n) acc[a][b][m][n] = (f32x4){0.f, 0.f, 0.f, 0.f};
    bf16x8 At[4][2], B0[2][2], B1[2][2];
    const char* cA = (const char*)g.A + (size_t)cur.pm * tstep; const char* cB = (const char*)g.Bt + (size_t)cur.pn * tstep;
    PG8_STAGE(PG8_SB(0, 0), cB, voffB); PG8_STAGE(PG8_SB(0, 1), cB + hstep, voffB); PG8_STAGE(PG8_SA(0, 0), cA, voffA); PG8_STAGE(PG8_SA(0, 1), cA + hstep, voffA);
    if (wr == 1) PG8_BAR;
    PG8_WAIT_V(2); PG8_BAR;
    PG8_STAGE(PG8_SB(1, 0), cB + kstep, voffB); PG8_STAGE(PG8_SA(1, 0), cA + kstep, voffA); PG8_STAGE(PG8_SB(1, 1), cB + hstep + kstep, voffB);
    PG8_WAIT_V(6); PG8_BAR;
    for (;;) {
        const bool has_next = S.next(ui + 1, nxt);
        const char* nA = has_next ? (const char*)g.A + (size_t)nxt.pm * tstep : cA; const char* nB = has_next ? (const char*)g.Bt + (size_t)nxt.pn * tstep : cB;
        for (int t = 0; t < nt; t += 2) {
            const bool last = (t == nt - 2);
            const char* a1 = cA + (size_t)(t + 1) * kstep;
            const char* a2 = last ? nA : cA + (size_t)(t + 2) * kstep; const char* b2 = last ? nB : cB + (size_t)(t + 2) * kstep;
            const char* a3 = a2 + kstep; const char* b3 = b2 + kstep;
            if constexpr (Epi::MIDK) { if (t == nt / 2) E.mid(acc, cur, wr, wc, fr, fq); }
            PG8_LDB(B0, 0, 0); PG8_LDB(B1, 0, 1); PG8_SCHED; PG8_LDA(At, 0, 0); PG8_STAGE(PG8_SA(1, 1), a1 + hstep, voffA);
            PG8_WAIT_V(8); PG8_WAIT_L(0); PG8_BAR; PG8_MMA(0, 0, At, B0); PG8_MMA(0, 1, At, B1); PG8_BAR; PG8_SCHED;
            PG8_LDA(At, 0, 1); PG8_STAGE(PG8_SB(0, 0), b2, voffB); PG8_STAGE(PG8_SB(0, 1), b2 + hstep, voffB); PG8_STAGE(PG8_SA(0, 0), a2, voffA);
            PG8_WAIT_V(8); PG8_WAIT_L(0); PG8_BAR; PG8_MMA(1, 0, At, B0); PG8_MMA(1, 1, At, B1); PG8_BAR; PG8_SCHED;
            PG8_LDB(B0, 1, 0); PG8_LDB(B1, 1, 1); PG8_SCHED; PG8_LDA(At, 1, 0); PG8_STAGE(PG8_SA(0, 1), a2 + hstep, voffA);
            PG8_WAIT_V(8); PG8_WAIT_L(0); PG8_BAR; PG8_MMA(0, 0, At, B0); PG8_MMA(0, 1, At, B1); PG8_BAR; PG8_SCHED;
            PG8_LDA(At, 1, 1); PG8_STAGE(PG8_SB(1, 0), b3, voffB); PG8_STAGE(PG8_SB(1, 1), b3 + hstep, voffB); PG8_STAGE(PG8_SA(1, 0), a3, voffA);
            PG8_WAIT_V(8); PG8_WAIT_L(0); PG8_BAR; PG8_MMA(1, 0, At, B0); PG8_MMA(1, 1, At, B1); PG8_BAR; PG8_SCHED;
        }
        if (wr == 0) PG8_BAR;
        E(acc, cur, wr, wc, fr, fq);
        if (!has_next) break;
#pragma unroll
        for (int a = 0; a < 2; ++a)
#pragma unroll
            for (int b = 0; b < 2; ++b)
#pragma unroll
                for (int m = 0; m < 4; ++m)
#pragma unroll
                    for (int n = 0; n < 2; ++n) acc[a][b][m][n] = (f32x4){0.f, 0.f, 0.f, 0.f};
        cur = nxt; cA = nA; cB = nB; ++ui;
        if (wr == 1) PG8_BAR;
    }
    PG8_WAIT_V(0);
    PG8_BAR;
#undef PG8_SA
#undef PG8_SB
#undef PG8_STAGE
#undef PG8_LDA
#undef PG8_LDB
#undef PG8_MMA
#undef PG8_WAIT_V
#undef PG8_WAIT_L
#undef PG8_BAR
#undef PG8_SCHED
}
}

typedef const f32x4 (&AccRef)[2][2][4][2];
typedef f32x4 (&AccMut)[2][2][4][2];
__device__ __forceinline__ u32x4 pack8(f32x4 a, f32x4 b) { u32x4 w; w.x = cvtpk(a[0], a[1]); w.y = cvtpk(a[2], a[3]); w.z = cvtpk(b[0], b[1]); w.w = cvtpk(b[2], b[3]); return w; }

struct EpiIn {
    static constexpr bool MIDK = false;
    bf16_t *RQK, *RV, *YB, *FK, *FV, *GRF;
    __device__ __forceinline__ void mid(AccMut, const pg8::Unit&, int, int, int, int) const {}
    __device__ __forceinline__ void operator()(AccRef acc, const pg8::Unit& u, int wr, int wc, int fr, int fq) const {
        const int pn = u.pn; int mode = 0, pitch = 1024, coff; bf16_t* base;
        if (pn < 4) { mode = pn < 2 ? 1 : 2; base = RQK; coff = pn * 256; }
        else if (pn < 8) { base = RV; coff = (pn - 4) * 256; }
        else if (pn < 12) { mode = 3; base = YB; pitch = 2048; coff = (pn - 8) * 256; }
        else if (pn < 16) { base = YB; pitch = 2048; coff = 1024 + (pn - 12) * 256; }
        else if (pn < 20) { base = FK; coff = (pn - 16) * 256; }
        else if (pn < 24) { base = FV; coff = (pn - 20) * 256; }
        else { mode = 4; base = GRF; pitch = 2048; coff = (pn - 24) * 256; }
        asm volatile("" : "+v"(fr), "+v"(fq));
        const int row0 = u.pm * 256 + wr * 64 + fr, col0 = coff + wc * 32 + 8 * fq;
        if (mode == 1 || mode == 2) {
            float fr4[4];
#pragma unroll
            for (int p = 0; p < 4; ++p) fr4[p] = powf(10000.0f, -(float)(16 * wc + 4 * fq + p) * (1.0f / 64.0f));
            const float ks = mode == 2 ? 0.08838834764831845f : 1.0f;
#pragma unroll
            for (int ai = 0; ai < 2; ++ai)
#pragma unroll
                for (int m = 0; m < 4; ++m) {
                    const int row = row0 + ai * 128 + m * 16; const float pos = (float)(row & (SEQ - 1));
                    float cs[4], sn[4];
#pragma unroll
                    for (int p = 0; p < 4; ++p) { const float ang = pos * fr4[p]; double t = (double)ang * 0.15915494309189535; t -= floor(t); const float tf = (float)t;
                        sn[p] = __builtin_amdgcn_sinf(tf) * ks; cs[p] = __builtin_amdgcn_cosf(tf) * ks; }
#pragma unroll
                    for (int bj = 0; bj < 2; ++bj) { const f32x4 v0 = acc[ai][bj][m][0], v1 = acc[ai][bj][m][1]; f32x4 o0, o1;
                        o0[0] = v0[0] * cs[0] - v0[1] * sn[0]; o0[1] = v0[0] * sn[0] + v0[1] * cs[0];
                        o0[2] = v0[2] * cs[1] - v0[3] * sn[1]; o0[3] = v0[2] * sn[1] + v0[3] * cs[1];
                        o1[0] = v1[0] * cs[2] - v1[1] * sn[2]; o1[1] = v1[0] * sn[2] + v1[1] * cs[2];
                        o1[2] = v1[2] * cs[3] - v1[3] * sn[3]; o1[3] = v1[2] * sn[3] + v1[3] * cs[3];
                        *(u32x4*)(base + (size_t)row * pitch + col0 + bj * 128) = pack8(o0, o1); }
                }
        } else {
#pragma unroll
            for (int ai = 0; ai < 2; ++ai)
#pragma unroll
                for (int m = 0; m < 4; ++m) {
                    const int row = row0 + ai * 128 + m * 16;
#pragma unroll
                    for (int bj = 0; bj < 2; ++bj) { f32x4 v0 = acc[ai][bj][m][0], v1 = acc[ai][bj][m][1];
                        if (mode == 3) {
#pragma unroll
                            for (int q = 0; q < 4; ++q) { v0[q] = siluf_(v0[q]); v1[q] = siluf_(v1[q]); } }
                        else if (mode == 4) {
#pragma unroll
                            for (int q = 0; q < 4; ++q) { v0[q] = sigmoidf_(v0[q]); v1[q] = sigmoidf_(v1[q]); } }
                        *(u32x4*)(base + (size_t)row * pitch + col0 + bj * 128) = pack8(v0, v1); }
                }
        }
    }
};
struct EpiMerge {
    static constexpr bool MIDK = true;
    const bf16_t* GRF; bf16_t* OUT;
    __device__ __forceinline__ void mid(AccMut acc, const pg8::Unit& u, int wr, int wc, int fr, int fq) const {
        asm volatile("" : "+v"(fr), "+v"(fq));
        const int row0 = u.pm * 256 + wr * 64 + fr, col0 = u.pn * 256 + wc * 32 + 8 * fq;
#pragma unroll
        for (int ai = 0; ai < 2; ++ai)
#pragma unroll
            for (int m = 0; m < 4; ++m) { const int row = row0 + ai * 128 + m * 16;
#pragma unroll
                for (int bj = 0; bj < 2; ++bj) { const u32x4 gr = *(const u32x4*)(GRF + (size_t)row * 2048 + col0 + bj * 128), gf = *(const u32x4*)(GRF + (size_t)row * 2048 + 1024 + col0 + bj * 128);
                    f32x4 r0, r1;
                    r0[0] = bflo(gr.x) / bflo(gf.x); r0[1] = bfhi(gr.x) / bfhi(gf.x); r0[2] = bflo(gr.y) / bflo(gf.y); r0[3] = bfhi(gr.y) / bfhi(gf.y);
                    r1[0] = bflo(gr.z) / bflo(gf.z); r1[1] = bfhi(gr.z) / bfhi(gf.z); r1[2] = bflo(gr.w) / bflo(gf.w); r1[3] = bfhi(gr.w) / bfhi(gf.w);
                    acc[ai][bj][m][0] *= r0; acc[ai][bj][m][1] *= r1; }
                __builtin_amdgcn_sched_barrier(0); }
    }
    __device__ __forceinline__ void operator()(AccRef acc, const pg8::Unit& u, int wr, int wc, int fr, int fq) const {
        asm volatile("" : "+v"(fr), "+v"(fq));
        const int row0 = u.pm * 256 + wr * 64 + fr, col0 = u.pn * 256 + wc * 32 + 8 * fq;
#pragma unroll
        for (int ai = 0; ai < 2; ++ai)
#pragma unroll
            for (int m = 0; m < 4; ++m) { const int row = row0 + ai * 128 + m * 16;
#pragma unroll
                for (int bj = 0; bj < 2; ++bj) { const u32x4 gf = *(const u32x4*)(GRF + (size_t)row * 2048 + 1024 + col0 + bj * 128);
                    f32x4 r0, r1; r0[0] = bflo(gf.x); r0[1] = bfhi(gf.x); r0[2] = bflo(gf.y); r0[3] = bfhi(gf.y); r1[0] = bflo(gf.z); r1[1] = bfhi(gf.z); r1[2] = bflo(gf.w); r1[3] = bfhi(gf.w);
                    *(u32x4*)(OUT + (size_t)row * 1024 + col0 + bj * 128) = pack8(acc[ai][bj][m][0] * r0, acc[ai][bj][m][1] * r1); } }
    }
};
struct EpiWout {
    static constexpr bool MIDK = false;
    const float* X; const float* MOD; const float* N2W; float* X1; bf16_t* A2; float* SSQ;
    __device__ __forceinline__ void mid(AccMut, const pg8::Unit&, int, int, int, int) const {}
    __device__ __forceinline__ void operator()(AccRef acc, const pg8::Unit& u, int wr, int wc, int fr, int fq) const {
        asm volatile("" : "+v"(fr), "+v"(fq));
        const int row0 = u.pm * 256 + wr * 64 + fr, col0 = u.pn * 256 + wc * 32 + 8 * fq; const int b = u.pm >> 5;
        const float* mod = MOD + b * 6144;
        f32x4 g1[2][2], w2[2][2];
#pragma unroll
        for (int bj = 0; bj < 2; ++bj)
#pragma unroll
            for (int n = 0; n < 2; ++n) { const int c = col0 + bj * 128 + 4 * n; g1[bj][n] = *(const f32x4*)(mod + 2048 + c);
                const f32x4 sc = *(const f32x4*)(mod + 4096 + c), nw = *(const f32x4*)(N2W + c); w2[bj][n] = nw * (sc + 1.0f); }
#pragma unroll
        for (int ai = 0; ai < 2; ++ai)
#pragma unroll
            for (int m = 0; m < 4; ++m) { const int row = row0 + ai * 128 + m * 16; float ss = 0.f;
#pragma unroll
                for (int bj = 0; bj < 2; ++bj) { const size_t off = (size_t)row * 1024 + col0 + bj * 128;
                    const f32x4 x0 = *(const f32x4*)(X + off), x1v = *(const f32x4*)(X + off + 4);
                    const f32x4 y0 = x0 + g1[bj][0] * acc[ai][bj][m][0], y1 = x1v + g1[bj][1] * acc[ai][bj][m][1];
                    *(f32x4*)(X1 + off) = y0; *(f32x4*)(X1 + off + 4) = y1;
                    ss += (y0[0] * y0[0] + y0[1] * y0[1]) + (y0[2] * y0[2] + y0[3] * y0[3]) + (y1[0] * y1[0] + y1[1] * y1[1]) + (y1[2] * y1[2] + y1[3] * y1[3]);
                    *(u32x4*)(A2 + off) = pack8(y0 * w2[bj][0], y1 * w2[bj][1]); }
                ss += __shfl_xor(ss, 16); ss += __shfl_xor(ss, 32);
                if (fq == 0) SSQ[(size_t)row * 16 + u.pn * 4 + wc] = ss; }
    }
};
struct EpiGU {
    static constexpr bool MIDK = false;
    const float* SSQ; const float* BIAS2; bf16_t* ACT;
    __device__ __forceinline__ void mid(AccMut, const pg8::Unit&, int, int, int, int) const {}
    __device__ __forceinline__ void operator()(AccRef acc, const pg8::Unit& u, int wr, int wc, int fr, int fq) const {
        asm volatile("" : "+v"(fr), "+v"(fq));
        const int row0 = u.pm * 256 + wr * 64 + fr, col0 = u.pn * 256 + wc * 32 + 8 * fq; const int b = u.pm >> 5;
        const float* bias = BIAS2 + b * NGU;
        f32x4 bv[2][2];
#pragma unroll
        for (int bj = 0; bj < 2; ++bj)
#pragma unroll
            for (int n = 0; n < 2; ++n) bv[bj][n] = *(const f32x4*)(bias + col0 + bj * 128 + 4 * n);
#pragma unroll
        for (int ai = 0; ai < 2; ++ai)
#pragma unroll
            for (int m = 0; m < 4; ++m) { const int row = row0 + ai * 128 + m * 16;
                const f32x4* sp = (const f32x4*)(SSQ + (size_t)row * 16); const f32x4 s0 = sp[0], s1 = sp[1], s2 = sp[2], s3 = sp[3];
                const float tot = ((s0[0] + s0[1]) + (s0[2] + s0[3])) + ((s1[0] + s1[1]) + (s1[2] + s1[3])) + ((s2[0] + s2[1]) + (s2[2] + s2[3])) + ((s3[0] + s3[1]) + (s3[2] + s3[3]));
                const float rstd = 1.0f / sqrtf(tot * (1.0f / 1024.0f) + EPS);
#pragma unroll
                for (int bj = 0; bj < 2; ++bj) { const f32x4 v0 = acc[ai][bj][m][0] * rstd + bv[bj][0], v1 = acc[ai][bj][m][1] * rstd + bv[bj][1];
                    u32x2 w; w.x = cvtpk(siluf_(v0[0]) * v0[1], siluf_(v0[2]) * v0[3]); w.y = cvtpk(siluf_(v1[0]) * v1[1], siluf_(v1[2]) * v1[3]);
                    *(u32x2*)(ACT + (size_t)row * DFF + ((col0 + bj * 128) >> 1)) = w; } }
    }
};
struct EpiDown {
    static constexpr bool MIDK = false;
    const float* MOD; float* X1; float* OUT;
    __device__ __forceinline__ void mid(AccMut, const pg8::Unit&, int, int, int, int) const {}
    __device__ __forceinline__ void operator()(AccRef acc, const pg8::Unit& u, int wr, int wc, int fr, int fq) const {
        asm volatile("" : "+v"(fr), "+v"(fq));
        const int row0 = u.pm * 256 + wr * 64 + fr, col0 = u.pn * 256 + wc * 32 + 8 * fq; const int b = u.pm >> 5;
        const float* mod = MOD + b * 6144 + 5120;
        f32x4 g2[2][2];
#pragma unroll
        for (int bj = 0; bj < 2; ++bj)
#pragma unroll
            for (int n = 0; n < 2; ++n) g2[bj][n] = *(const f32x4*)(mod + col0 + bj * 128 + 4 * n);
#pragma unroll
        for (int ai = 0; ai < 2; ++ai)
#pragma unroll
            for (int m = 0; m < 4; ++m) { const int row = row0 + ai * 128 + m * 16;
#pragma unroll
                for (int bj = 0; bj < 2; ++bj) { const size_t off = (size_t)row * 1024 + col0 + bj * 128;
                    const f32x4 x0 = *(const f32x4*)(X1 + off), x1v = *(const f32x4*)(X1 + off + 4);
                    *(f32x4*)(OUT + off) = x0 + g2[bj][0] * acc[ai][bj][m][0]; *(f32x4*)(OUT + off + 4) = x1v + g2[bj][1] * acc[ai][bj][m][1]; } }
    }
};

namespace fox {
constexpr int D = 128, QP = 2048, KVP = 1024;
constexpr float SCALE = 0.08838834764831845f, THR = 8.f;
constexpr int NW = 8, QBLK = 32, KVBLK = 64, QB = NW * QBLK;
constexpr int SHM_V = KVBLK * D * 2, SHM_K = KVBLK * D * 2;
constexpr int LDS_G = 2 * SHM_V + 2 * SHM_K + NW * 64 * 4;
constexpr int LDS_BYTES = LDS_G + 2 * 64 * 4;
#define KSWZ(row, colB) ((row) * 256 + ((colB) ^ (((row) & 7) << 4)))
#define SBAR() __builtin_amdgcn_sched_barrier(0)
__device__ __forceinline__ int v_st(int k, int c) { const int kk = (k & ~0xC) | ((k & 4) << 1) | ((k & 8) >> 1); return ((kk >> 3) * 4 + (c >> 5)) * 512 + ((kk & 7) * 32 + (c & 31)) * 2; }
__device__ __forceinline__ int v_rd_base(int lane) { return ((lane & 3) << 3) | (((lane >> 2) & 3) << 6) | (((lane >> 4) & 1) << 5) | (((lane >> 5) & 1) << 8); }
constexpr int v_rd_off(int d0, int ks, int half) { return d0 * 512 + ks * 4096 + half * 2048; }
__device__ __forceinline__ int crow(int r, int hi) { return (r & 3) + 8 * (r >> 2) + 4 * hi; }
__device__ __forceinline__ unsigned cvtpk_a(float lo, float hi) { unsigned r; asm volatile("v_cvt_pk_bf16_f32 %0, %1, %2" : "=v"(r) : "v"(lo), "v"(hi)); return r; }
__device__ __forceinline__ bf16x8 load8(const bf16_t* p) { return *reinterpret_cast<const bf16x8*>(p); }
__device__ __forceinline__ bf16x8 ldu(const void* ubase, unsigned off) { return *reinterpret_cast<const bf16x8*>((const char*)ubase + off); }
__device__ __forceinline__ void mask_tile(f32x16& p0, f32x16& p1, int dq) {
    const float NEG = -__builtin_inff();
#pragma unroll
    for (int r = 0; r < 16; ++r) { const int c = (r & 3) + 8 * (r >> 2); if (dq - c < 0) p0[r] = NEG; if (dq - c - 32 < 0) p1[r] = NEG; }
}
__device__ __forceinline__ void partialSM(f32x16& p0, f32x16& p1, float& m_reg, float& mn, float& alpha) {
    float pmax = p0[0];
#pragma unroll
    for (int r = 1; r < 16; ++r) pmax = fmaxf(pmax, p0[r]);
#pragma unroll
    for (int r = 0; r < 16; ++r) pmax = fmaxf(pmax, p1[r]);
    { auto rr = __builtin_amdgcn_permlane32_swap(__float_as_uint(pmax), __float_as_uint(pmax), false, false);
      pmax = fmaxf(__uint_as_float(rr[0]), __uint_as_float(rr[1])); }
    constexpr float C2 = 1.4426950408889634f * SCALE;
    if (__builtin_expect(__all((pmax - m_reg) * SCALE <= THR), 1)) { mn = m_reg; alpha = 1.f; }
    else { mn = fmaxf(m_reg, pmax); alpha = __builtin_amdgcn_exp2f((m_reg - mn) * C2); m_reg = mn; }
    const float mnL = -mn * C2;
#pragma unroll
    for (int r = 0; r < 16; ++r) p0[r] = fmaf(p0[r], C2, mnL);
#pragma unroll
    for (int r = 0; r < 16; ++r) p1[r] = fmaf(p1[r], C2, mnL);
#pragma unroll
    for (int r = 0; r < 16; ++r) p0[r] = __builtin_amdgcn_exp2f(p0[r]);
}
__device__ __forceinline__ void finishSM(f32x16& p0, f32x16& p1, float alpha, float& l_reg, bf16x8& pa0, bf16x8& pa1, bf16x8& pa2, bf16x8& pa3) {
#pragma unroll
    for (int r = 0; r < 16; ++r) p1[r] = __builtin_amdgcn_exp2f(p1[r]);
    float ps = 0;
#pragma unroll
    for (int r = 0; r < 16; ++r) ps += p0[r];
#pragma unroll
    for (int r = 0; r < 16; ++r) ps += p1[r];
    { auto rr = __builtin_amdgcn_permlane32_swap(__float_as_uint(ps), __float_as_uint(ps), false, false);
      ps = __uint_as_float(rr[0]) + __uint_as_float(rr[1]); }
    l_reg = l_reg * alpha + ps;
#define PK4(P, B_, OUT) do { unsigned a0 = cvtpk_a(P[B_+0], P[B_+1]), a1 = cvtpk_a(P[B_+2], P[B_+3]);                          \
        unsigned b0 = cvtpk_a(P[B_+4], P[B_+5]), b1 = cvtpk_a(P[B_+6], P[B_+7]);                                             \
        auto r0 = __builtin_amdgcn_permlane32_swap(a0, b0, false, false); auto r1 = __builtin_amdgcn_permlane32_swap(a1, b1, false, false); \
        u32x4 w = {r0[0], r1[0], r0[1], r1[1]}; OUT = *reinterpret_cast<bf16x8*>(&w); } while (0)
    PK4(p0, 0, pa0); PK4(p0, 8, pa1); PK4(p1, 0, pa2); PK4(p1, 8, pa3);
#undef PK4
}
template <int KB>
__device__ __forceinline__ void qkt(f32x16& p0, f32x16& p1, const char* K_lds, const char* G_lds, int r32, int hi, const bf16x8* qr) {
    const f32x4* gl = (const f32x4*)(G_lds + KB * 256 + hi * 16);
#pragma unroll
    for (int j = 0; j < 4; ++j) { const f32x4 a = gl[2 * j], b = gl[8 + 2 * j];
#pragma unroll
        for (int i = 0; i < 4; ++i) { p0[4 * j + i] = a[i]; p1[4 * j + i] = b[i]; } }
    const char* kb[4];
#pragma unroll
    for (int dd = 0; dd < 4; ++dd) kb[dd] = K_lds + KB * SHM_K + KSWZ(r32, (dd * 16 + hi * 8) * 2);
#pragma unroll
    for (int d0 = 0; d0 < 8; ++d0) { const char* a = kb[d0 & 3] + (d0 >> 2) * 128;
        bf16x8 b0 = *reinterpret_cast<const bf16x8*>(a);
        bf16x8 b1 = *reinterpret_cast<const bf16x8*>(a + 32 * 256);
        p0 = __builtin_amdgcn_mfma_f32_32x32x16_bf16(b0, qr[d0], p0, 0, 0, 0);
        p1 = __builtin_amdgcn_mfma_f32_32x32x16_bf16(b1, qr[d0], p1, 0, 0, 0); }
}
template <int VB>
__device__ __forceinline__ void pv_tile(f32x16* o, int vb0, bf16x8 pa0, bf16x8 pa1, bf16x8 pa2, bf16x8 pa3) {
#define TRRD(dst, off) asm volatile("ds_read_b64_tr_b16 %0, %1 offset:%2" : "=&v"(dst) : "v"(vb0), "i"(off) : "memory")
#define PV_D0(d0) do { s16x4 l0, l1, l2, l3, h0, h1, h2, h3; constexpr int b_ = VB * SHM_V + v_rd_off(d0, 0, 0); \
        TRRD(l0, b_); TRRD(h0, b_ + 2048); TRRD(l1, b_ + 4096); TRRD(h1, b_ + 6144); TRRD(l2, b_ + 8192); TRRD(h2, b_ + 10240); TRRD(l3, b_ + 12288); TRRD(h3, b_ + 14336); \
        asm volatile("s_waitcnt lgkmcnt(0)" ::: "memory"); SBAR();   \
        o[d0] = __builtin_amdgcn_mfma_f32_32x32x16_bf16(pa0, (bf16x8){l0[0], l0[1], l0[2], l0[3], h0[0], h0[1], h0[2], h0[3]}, o[d0], 0, 0, 0);   \
        o[d0] = __builtin_amdgcn_mfma_f32_32x32x16_bf16(pa1, (bf16x8){l1[0], l1[1], l1[2], l1[3], h1[0], h1[1], h1[2], h1[3]}, o[d0], 0, 0, 0);   \
        o[d0] = __builtin_amdgcn_mfma_f32_32x32x16_bf16(pa2, (bf16x8){l2[0], l2[1], l2[2], l2[3], h2[0], h2[1], h2[2], h2[3]}, o[d0], 0, 0, 0);   \
        o[d0] = __builtin_amdgcn_mfma_f32_32x32x16_bf16(pa3, (bf16x8){l3[0], l3[1], l3[2], l3[3], h3[0], h3[1], h3[2], h3[3]}, o[d0], 0, 0, 0); } while (0)
    PV_D0(0); PV_D0(1); PV_D0(2); PV_D0(3);
#undef PV_D0
#undef TRRD
}
struct BlockRef { const bf16_t* Q; const bf16_t* K; const bf16_t* V; bf16_t* O; const float* G; int P0; };
struct Seam { bf16x8 qr[8]; bf16x8 st_v0, st_v1, st_k0, st_k1; float g0, g1; };
#define ROW(p, k0, rr) ((p) + (size_t)((k0) + (rr)) * KVP + sc)
#define VMW() asm volatile("s_waitcnt vmcnt(0)" ::: "memory")
#define VMWN(n) asm volatile("s_waitcnt vmcnt(%0)" :: "i"(n) : "memory")
#define SLOAD_H(Kp, Vp, Gp, gqv, k0) do { const bf16_t* kt_ = (Kp) + (size_t)(k0) * KVP; const bf16_t* vt_ = (Vp) + (size_t)(k0) * KVP; const float* gt_ = (Gp) + (k0); \
                         S.st_v0 = ldu(vt_, loff); S.st_v1 = ldu(vt_ + 32 * KVP, loff); S.st_k0 = ldu(kt_, loff); S.st_k1 = ldu(kt_ + 32 * KVP, loff); \
                         S.g0 = (gqv) - *(const float*)((const char*)gt_ + goff); S.g1 = (gqv) - *(const float*)((const char*)(gt_ + 32) + goff); } while (0)
#define SWRITE_HK(bf) do { *(bf16x8*)(K_lds + (bf) * SHM_K + kws) = S.st_k0; *(bf16x8*)(K_lds + (bf) * SHM_K + kws + 32 * 256) = S.st_k1; \
                           if ((tid & 15) == 0) { ((float*)(G_lds + (bf) * 256))[sr] = S.g0; ((float*)(G_lds + (bf) * 256))[32 + sr] = S.g1; } } while (0)
#define SWRITE_HV(bf) do { *(bf16x8*)(V_lds + (bf) * SHM_V + vst0) = S.st_v0; *(bf16x8*)(V_lds + (bf) * SHM_V + vst1) = S.st_v1; } while (0)
#define SWRITE_H(bf) do { SWRITE_HV(bf); SWRITE_HK(bf); } while (0)
__device__ __forceinline__ void prime(const BlockRef& cur, char* lds, Seam& S) {
    int tid = threadIdx.x; asm volatile("" : "+v"(tid)); const int wid = __builtin_amdgcn_readfirstlane(tid >> 6), lane = tid & 63, r32 = lane & 31, hi = lane >> 5;
    const int sr = tid >> 4, sc = (tid & 15) * 8, kws = KSWZ(sr, sc * 2); char* K_lds = lds + 2 * SHM_V; char* G_lds = lds + LDS_G;
    const unsigned loff = (unsigned)(sr * KVP + sc) * 2u, goff = (unsigned)sr * 4u, qoff = (unsigned)(r32 * QP + hi * 8) * 2u;
    { const bf16_t* qb_ = cur.Q + (size_t)(wid * QBLK) * QP;
#pragma unroll
    for (int d0 = 0; d0 < 8; ++d0) S.qr[d0] = ldu(qb_ + d0 * 16, qoff); }
    SLOAD_H(cur.K, cur.V, cur.G, cur.G[cur.P0], 0); VMW(); SWRITE_HK(0);
    __syncthreads();
}
__device__ __forceinline__ void block(const BlockRef& cur, const BlockRef& nxt, char* lds, Seam& S) {
    int tid = threadIdx.x; asm volatile("" : "+v"(tid)); const int wid = __builtin_amdgcn_readfirstlane(tid >> 6), lane = tid & 63, r32 = lane & 31, hi = lane >> 5;
    const int NT = (cur.P0 + QB) / KVBLK;
    const int qlo = cur.P0 + wid * QBLK, qm = qlo + r32 - 4 * hi;
    char* V_lds = lds; char* K_lds = lds + 2 * SHM_V; char* G_lds = lds + LDS_G;
    float* ws = (float*)(lds + 2 * SHM_V + 2 * SHM_K) + wid * 64; float* li_l = ws, * al_l = ws + 32;
    float m_reg = -1e30f, l_reg = 0; f32x16 o[4] = {};
    const int sr = tid >> 4, sc = (tid & 15) * 8, vst0 = v_st(sr, sc), vst1 = v_st(32 + sr, sc), kws = KSWZ(sr, sc * 2);
    const unsigned loff = (unsigned)(sr * KVP + sc) * 2u, goff = (unsigned)sr * 4u, qoff = (unsigned)(r32 * QP + hi * 8) * 2u;
    const int vb0 = (int)(uintptr_t)V_lds + v_rd_base(lane);
    const bf16_t* Kh = cur.K; const bf16_t* Vh = cur.V; const float* Gh = cur.G;
    const float gq = Gh[cur.P0];
#define RESC(a) do { if (__any((a) < 1.f)) { if (hi == 0) al_l[r32] = (a); asm volatile("s_waitcnt lgkmcnt(0)" ::: "memory");              \
                     for (int d_ = 0; d_ < 4; ++d_) for (int r = 0; r < 16; ++r) o[d_][r] *= al_l[crow(r, hi)]; } } while (0)
#define KBASE(t) ((t) * KVBLK)
#define MASKT(P0_, P1_, t) do { const int kb_ = KBASE(t); if (kb_ + KVBLK - 1 > qlo) mask_tile(P0_, P1_, qm - kb_); } while (0)
    constexpr int NQL = 8;
#define SEAM_K0() do { VMWN(NQL); SWRITE_HK(0); SBAR(); } while (0)
    f32x16 pA0, pA1, pB0, pB1; float mnA, mnB, alA, alB; bf16x8 pa0, pa1, pa2, pa3;
    SWRITE_HV(0); SBAR();
    if (NT > 1) { SLOAD_H(Kh, Vh, Gh, gq, KBASE(1)); }
    SBAR(); qkt<0>(pA0, pA1, K_lds, G_lds, r32, hi, S.qr);
    MASKT(pA0, pA1, 0); partialSM(pA0, pA1, m_reg, mnA, alA);
    if (NT > 1) { VMW(); SWRITE_H(1); }
    __syncthreads();
#define HALF_STEP(PX0, PX1, mnX, alX, PY0, PY1, alY, t, KB, VB, SB) do {                                                      \
        SBAR(); qkt<KB>(PX0, PX1, K_lds, G_lds, r32, hi, S.qr);                                             \
        finishSM(PY0, PY1, alY, l_reg, pa0, pa1, pa2, pa3); SBAR();                                                           \
        if ((t) + 1 < NT) { SLOAD_H(Kh, Vh, Gh, gq, KBASE((t) + 1)); SBAR(); }                                               \
        pv_tile<VB>(o, vb0, pa0, pa1, pa2, pa3); MASKT(PX0, PX1, (t)); partialSM(PX0, PX1, m_reg, mnX, alX);                                        \
        __syncthreads();                                                                                                      \
        if ((t) + 1 < NT) { VMW(); SWRITE_H(SB); }                                                                          \
        RESC(alX); __syncthreads(); } while (0)
    for (int t = 1; t + 1 < NT; t += 2) {
        HALF_STEP(pB0, pB1, mnB, alB, pA0, pA1, alA, t, 1, 0, 0);
        HALF_STEP(pA0, pA1, mnA, alA, pB0, pB1, alB, t + 1, 0, 1, 1);
    }
    { SBAR(); qkt<1>(pB0, pB1, K_lds, G_lds, r32, hi, S.qr); SBAR(); }
    SLOAD_H(nxt.K, nxt.V, nxt.G, nxt.G[nxt.P0], 0); SBAR();
    { const bf16_t* qb_ = nxt.Q + (size_t)(wid * QBLK) * QP;
#pragma unroll
    for (int d0 = 0; d0 < 8; ++d0) S.qr[d0] = ldu(qb_ + d0 * 16, qoff); }
    SBAR();
    finishSM(pA0, pA1, alA, l_reg, pa0, pa1, pa2, pa3); SBAR();
    pv_tile<0>(o, vb0, pa0, pa1, pa2, pa3);
    { MASKT(pB0, pB1, NT - 1); partialSM(pB0, pB1, m_reg, mnB, alB); __syncthreads(); RESC(alB);
      finishSM(pB0, pB1, alB, l_reg, pa0, pa1, pa2, pa3); SBAR(); pv_tile<1>(o, vb0, pa0, pa1, pa2, pa3); }
    SBAR(); SEAM_K0();
    if (hi == 0) li_l[r32] = l_reg; asm volatile("s_waitcnt lgkmcnt(0)" ::: "memory");
    float rli[16];
#pragma unroll
    for (int r = 0; r < 16; ++r) rli[r] = __builtin_amdgcn_rcpf(li_l[crow(r, hi)]);
    bf16_t* Ow = cur.O + (size_t)(wid * QBLK) * QP;
    unsigned ooff = (unsigned)(4 * hi * QP + r32) * 2u; asm volatile("" : "+v"(ooff));
#pragma unroll
    for (int r = 0; r < 16; ++r) { char* orp = (char*)(Ow + (size_t)((r & 3) + 8 * (r >> 2)) * QP);
#pragma unroll
        for (int d0 = 0; d0 < 4; ++d0) { const float v = o[d0][r] * rli[r];
            const float vn = __shfl_xor(v, 1);
            if ((r32 & 1) == 0) *(unsigned*)(orp + ooff + d0 * 64) = cvtpk_a(v, vn); } }
    __syncthreads();
#undef RESC
#undef KBASE
#undef MASKT
#undef SEAM_K0
#undef HALF_STEP
}
#undef ROW
#undef VMW
#undef VMWN
#undef SLOAD_H
#undef SWRITE_HK
#undef SWRITE_HV
#undef SWRITE_H
#undef KSWZ
#undef SBAR
}

namespace ret {
constexpr int PQ = 272, PT = 144, PO = 528;
constexpr int L_Q = 0, L_K = 64 * PQ, L_KT = L_K + 64 * PQ, L_VT = L_KT + 128 * PT, L_P = L_VT + 256 * PT, L_O = L_P + 64 * PT, L_END = L_O + 64 * PO;
static_assert(L_END <= 140000, "retention LDS");
constexpr int NCH = 4, NGRP = 128 / NCH;
__device__ __forceinline__ int crow(int r, int hi) { return (r & 3) + 8 * (r >> 2) + 4 * hi; }
#define MF32(a, b, c) __builtin_amdgcn_mfma_f32_32x32x16_bf16((a), (b), (c), 0, 0, 0)
__device__ __forceinline__ bf16x8 ld16(const LAS unsigned char* p) { return *(const LAS bf16x8*)p; }
template <bool PH2, bool DRY = false>
__device__ __forceinline__ void unit(int bh, int g, const bf16_t* RQK, const bf16_t* RV, bf16_t* YB, float* GS, LAS unsigned char* lds, bf16_t* dummy = nullptr) {
    int tid = threadIdx.x; asm volatile("" : "+v"(tid)); const int w = __builtin_amdgcn_readfirstlane(tid >> 6), lane = tid & 63, r32 = lane & 31, hi = lane >> 5;
    const int b = bh >> 2, h = bh & 3;
    const float lg = log2f(1.0f - exp2f(-5.0f - (float)h));
    const float dchunk = exp2f(64.f * lg);
    f32x16 st[4];
#pragma unroll
    for (int db = 0; db < 4; ++db) st[db] = f32x16{};
    if (PH2 && g > 0) {
        const float* src = GS + ((size_t)(bh * NGRP + g - 1) * 128) * 256 + 32 * w + r32;
#pragma unroll
        for (int db = 0; db < 4; ++db)
#pragma unroll
            for (int r = 0; r < 16; ++r) st[db][r] = src[(size_t)(32 * db + crow(r, hi)) * 256];
    }
    const int sj = tid & 63, sc0 = tid >> 6;
    const int r32_0 = r32, hi_0 = hi, sj_0 = sj;
    u32x4 pq[2], pk[2], pvv[4], prg[4];
#define RET_LOAD(cix) do { const size_t t0_ = (size_t)b * SEQ + (size_t)(g * NCH + (cix)) * 64; const bf16_t* rowp_ = RQK + (t0_ + sj_0) * 1024 + h * 128; const bf16_t* vrow_ = RV + (t0_ + sj_0) * 1024 + h * 256; \
        _Pragma("unroll") for (int m = 0; m < 2; ++m) { pk[m] = *(const u32x4*)(rowp_ + 512 + (sc0 + 8 * m) * 8); if (PH2) pq[m] = *(const u32x4*)(rowp_ + (sc0 + 8 * m) * 8); } \
        _Pragma("unroll") for (int m = 0; m < 4; ++m) pvv[m] = *(const u32x4*)(vrow_ + (sc0 + 8 * m) * 8); } while (0)
    RET_LOAD(0);
    for (int ci = 0; ci < NCH; ++ci) {
        const size_t tok0 = (size_t)b * SEQ + (size_t)(g * NCH + ci) * 64;
        int r32 = r32_0, hi = hi_0, sj = sj_0; asm volatile("" : "+v"(r32), "+v"(hi), "+v"(sj));
        const float kdec = exp2f((64.f - (float)sj) * lg);
        {
#pragma unroll
            for (int m = 0; m < 2; ++m) { const int c = sc0 + 8 * m;
                const u32x4 kv = pk[m];
                if (PH2) { *(LAS u32x4*)(lds + L_Q + sj * PQ + c * 16) = pq[m]; *(LAS u32x4*)(lds + L_K + sj * PQ + c * 16) = kv; }
                const unsigned kw[4] = {kv.x, kv.y, kv.z, kv.w};
#pragma unroll
                for (int q = 0; q < 4; ++q) { const unsigned pkk = cvtpk(bflo(kw[q]) * kdec, bfhi(kw[q]) * kdec);
                    *(LAS unsigned short*)(lds + L_KT + (c * 8 + 2 * q) * PT + sj * 2) = (unsigned short)(pkk & 0xffffu);
                    *(LAS unsigned short*)(lds + L_KT + (c * 8 + 2 * q + 1) * PT + sj * 2) = (unsigned short)(pkk >> 16); } }
#pragma unroll
            for (int m = 0; m < 4; ++m) { const int c = sc0 + 8 * m; const u32x4 vv = pvv[m];
                const unsigned vw[4] = {vv.x, vv.y, vv.z, vv.w};
#pragma unroll
                for (int q = 0; q < 4; ++q) {
                    *(LAS unsigned short*)(lds + L_VT + (c * 8 + 2 * q) * PT + sj * 2) = (unsigned short)(vw[q] & 0xffffu);
                    *(LAS unsigned short*)(lds + L_VT + (c * 8 + 2 * q + 1) * PT + sj * 2) = (unsigned short)(vw[q] >> 16); } }
            if (ci + 1 < NCH) RET_LOAD(ci + 1);
            if (PH2) { const bf16_t* yp_ = YB + (tok0 + (tid >> 3)) * 2048 + h * 256 + (tid & 7) * 32;
#pragma unroll
                for (int q = 0; q < 4; ++q) prg[q] = *(const u32x4*)(yp_ + q * 8); }
        }
        __syncthreads();
        bf16x8 vf[4];
#pragma unroll
        for (int k0 = 0; k0 < 4; ++k0) vf[k0] = ld16(lds + L_VT + (32 * w + r32) * PT + (k0 * 16 + 8 * hi) * 2);
        if (PH2) {
            if (w < 4) { const int ib = w >> 1, jb = w & 1; f32x16 s = f32x16{};
#pragma unroll
                for (int k0 = 0; k0 < 8; ++k0) s = MF32(ld16(lds + L_Q + (32 * ib + r32) * PQ + (k0 * 16 + 8 * hi) * 2), ld16(lds + L_K + (32 * jb + r32) * PQ + (k0 * 16 + 8 * hi) * 2), s);
                const int j = 32 * jb + r32;
#pragma unroll
                for (int r = 0; r < 16; ++r) { const int i = 32 * ib + crow(r, hi); const int dd = i > j ? i - j : j - i;
                    const float pv = s[r] * exp2f((float)dd * lg);
                    *(LAS unsigned short*)(lds + L_P + i * PT + j * 2) = (unsigned short)(cvtpk(pv, 0.f) & 0xffffu); } }
            __syncthreads();
            bf16x8 sb[4][2];
#pragma unroll
            for (int db = 0; db < 4; ++db)
#pragma unroll
                for (int kk = 0; kk < 2; ++kk) { u32x4 p; p.x = cvtpk(st[db][8 * kk + 0], st[db][8 * kk + 1]); p.y = cvtpk(st[db][8 * kk + 2], st[db][8 * kk + 3]);
                    p.z = cvtpk(st[db][8 * kk + 4], st[db][8 * kk + 5]); p.w = cvtpk(st[db][8 * kk + 6], st[db][8 * kk + 7]); sb[db][kk] = __builtin_bit_cast(bf16x8, p); }
#pragma unroll
            for (int ib = 0; ib < 2; ++ib) {
                f32x16 ao = f32x16{}, ai = f32x16{};
#pragma unroll
                for (int k0 = 0; k0 < 4; ++k0) ao = MF32(ld16(lds + L_P + (32 * ib + r32) * PT + (k0 * 16 + 8 * hi) * 2), vf[k0], ao);
#pragma unroll
                for (int db = 0; db < 4; ++db)
#pragma unroll
                    for (int kk = 0; kk < 2; ++kk) { const LAS unsigned char* qp = lds + L_Q + (32 * ib + r32) * PQ + (32 * db + 16 * kk + 4 * hi) * 2;
                        const u32x2 lo = *(const LAS u32x2*)qp, hi2 = *(const LAS u32x2*)(qp + 16); u32x4 a; a.x = lo.x; a.y = lo.y; a.z = hi2.x; a.w = hi2.y;
                        ai = MF32(__builtin_bit_cast(bf16x8, a), sb[db][kk], ai); }
                __builtin_amdgcn_sched_barrier(0);
#pragma unroll
                for (int r = 0; r < 16; ++r) { const int i = 32 * ib + crow(r, hi); const float ov = ao[r] + exp2f((float)i * lg) * ai[r];
                    *(LAS unsigned short*)(lds + L_O + i * PO + (32 * w + r32) * 2) = (unsigned short)(cvtpk(ov, 0.f) & 0xffffu); }
                __builtin_amdgcn_sched_barrier(0);
            }
        }
#pragma unroll
        for (int db = 0; db < 4; ++db) { f32x16 s = st[db] * dchunk;
#pragma unroll
            for (int k0 = 0; k0 < 4; ++k0) s = MF32(ld16(lds + L_KT + (32 * db + r32) * PT + (k0 * 16 + 8 * hi) * 2), vf[k0], s);
            st[db] = s; __builtin_amdgcn_sched_barrier(0); }
        __syncthreads();
        if (PH2) {
            int tid_o = tid; asm volatile("" : "+v"(tid_o)); const int i = tid_o >> 3, seg = tid_o & 7;
            const LAS unsigned char* op = lds + L_O + i * PO + seg * 64;
            float v[32]; float ss = 0.f;
#pragma unroll
            for (int q = 0; q < 4; ++q) { const u32x4 ow = *(const LAS u32x4*)(op + q * 16); const unsigned oo[4] = {ow.x, ow.y, ow.z, ow.w};
#pragma unroll
                for (int z = 0; z < 4; ++z) { v[q * 8 + 2 * z] = bflo(oo[z]); v[q * 8 + 2 * z + 1] = bfhi(oo[z]); } }
#pragma unroll
            for (int z = 0; z < 32; ++z) ss += v[z] * v[z];
            ss += __shfl_xor(ss, 1); ss += __shfl_xor(ss, 2); ss += __shfl_xor(ss, 4);
            const float rstd = 1.0f / sqrtf(ss * (1.0f / 256.0f) + EPS);
            bf16_t* yp = YB + (tok0 + i) * 2048 + h * 256 + seg * 32;
#pragma unroll
            for (int q = 0; q < 4; ++q) { const u32x4 gw = prg[q]; const unsigned gg[4] = {gw.x, gw.y, gw.z, gw.w}; u32x4 o;
                unsigned oo[4];
#pragma unroll
                for (int z = 0; z < 4; ++z) oo[z] = cvtpk(bflo(gg[z]) * v[q * 8 + 2 * z] * rstd, bfhi(gg[z]) * v[q * 8 + 2 * z + 1] * rstd);
                o.x = oo[0]; o.y = oo[1]; o.z = oo[2]; o.w = oo[3]; *(u32x4*)((DRY ? dummy + i * 2048 + seg * 32 : yp) + q * 8) = o; }
            __syncthreads();
        }
    }
    if (!PH2) { float* dst = GS + ((size_t)(bh * NGRP + g) * 128) * 256 + 32 * w + r32;
#pragma unroll
        for (int db = 0; db < 4; ++db)
#pragma unroll
            for (int r = 0; r < 16; ++r) dst[(size_t)(32 * db + crow(r, hi)) * 256] = st[db][r]; }
}
#undef MF32
#undef RET_LOAD
}


#define XB_TMO      128
#define XB_XCNT(j)  (256  + 64 * (j))
#define XB_XSUB(j)  (1280 + 64 * (j))
#define XB_XGEN(j)  (2304 + 64 * (j))
#define XB_TOP      3328
#define XB_TOPGEN   3392
#define XCD_BAR_WORDS 3456
#define XB_SPIN_CAP (1u << 18)
__device__ __forceinline__ unsigned xb_ld(unsigned* p)              { return __hip_atomic_load(p, __ATOMIC_RELAXED, __HIP_MEMORY_SCOPE_AGENT); }
__device__ __forceinline__ unsigned xb_add(unsigned* p, unsigned v) { return __hip_atomic_fetch_add(p, v, __ATOMIC_RELAXED, __HIP_MEMORY_SCOPE_AGENT); }
__device__ __forceinline__ unsigned xb_xcc_id() { return (unsigned)__builtin_amdgcn_s_getreg((3 << 11) | 20) & 0xFu; }
#define XB_SPIN(cond, bar) do { unsigned _sp = 0; while (cond) { __builtin_amdgcn_s_sleep(1); \
    if ((++_sp & 255u) == 0u) { if (xb_ld(&(bar)[XB_TMO])) break; if (_sp > XB_SPIN_CAP) { atomicAdd(&(bar)[XB_TMO], 1u); break; } } } } while (0)
struct XcdBarrier { unsigned* bar; unsigned x; volatile LAS unsigned* st; };
__device__ __forceinline__ XcdBarrier xcd_barrier_post(unsigned* bar, volatile LAS unsigned* st) {
    XcdBarrier b; b.bar = bar; b.x = xb_xcc_id(); b.st = st;
    if (threadIdx.x == 0) (void)xb_add(&bar[XB_XCNT(b.x)], 1u);
    return b;
}
__device__ __forceinline__ void xcd_barrier_complete(unsigned* bar, unsigned x, unsigned& nloc, unsigned& nx) {
    const unsigned G = gridDim.x * gridDim.y * gridDim.z;
    unsigned sum, cnt, mine, sp = 0u;
    for (;;) {
        sum = 0u; cnt = 0u; mine = 0u;
#pragma unroll
        for (unsigned j = 0; j < 16; ++j) { const unsigned c = xb_ld(&bar[XB_XCNT(j)]); sum += c; cnt += (c > 0u) ? 1u : 0u; mine = (j == x) ? c : mine; }
        if (sum == G) break;
        __builtin_amdgcn_s_sleep(1);
        if ((++sp & 255u) == 0u) { if (xb_ld(&bar[XB_TMO])) break; if (sp > XB_SPIN_CAP) { atomicAdd(&bar[XB_TMO], 1u); break; } }
    }
    nloc = mine > 0u ? mine : 1u; nx = cnt > 0u ? cnt : 1u;
}
__device__ __forceinline__ void xcd_barrier(const XcdBarrier& b) {
    asm volatile("s_waitcnt vmcnt(0)" ::: "memory");
    __syncthreads();
    if (threadIdx.x == 0) {
        unsigned* bar = b.bar;
        __builtin_amdgcn_s_waitcnt(0);
        unsigned nloc = b.st[0], nx = b.st[1];
        if (nloc == 0u) { xcd_barrier_complete(bar, b.x, nloc, nx); b.st[0] = nloc; b.st[1] = nx; }
        const unsigned old = xb_add(&bar[XB_XSUB(b.x)], 1u);
        const unsigned gen = old / nloc;
        if (old + 1u == (gen + 1u) * nloc) {
            __builtin_amdgcn_fence(__ATOMIC_RELEASE, "agent");
            asm volatile("s_waitcnt vmcnt(0)" ::: "memory");
            const unsigned og = xb_add(&bar[XB_TOP], 1u);
            const unsigned tg = og / nx;
            if (og + 1u == (tg + 1u) * nx) xb_add(&bar[XB_TOPGEN], 1u);
            else XB_SPIN(xb_ld(&bar[XB_TOPGEN]) == tg, bar);
            __builtin_amdgcn_fence(__ATOMIC_ACQUIRE, "agent");
            xb_add(&bar[XB_XGEN(b.x)], 1u);
            asm volatile("s_waitcnt vmcnt(0)" ::: "memory");
        } else {
            XB_SPIN(xb_ld(&bar[XB_XGEN(b.x)]) == gen, bar);
            __builtin_amdgcn_fence(__ATOMIC_ACQUIRE, "agent");
            asm volatile("s_waitcnt vmcnt(0)" ::: "memory");
        }
    }
    __syncthreads();
}

__device__ __forceinline__ void transpose_item(const float* colp, int ldw, int k0, bf16_t* WT, size_t ldt, int n0, LAS float* scr, int lane) {
#pragma unroll 8
    for (int i = 0; i < 32; ++i) { const int kk = 2 * i + (lane >> 5); scr[kk * 33 + (lane & 31)] = colp[(size_t)(k0 + kk) * ldw]; }
    LDS_WAIT(); asm volatile("" ::: "memory");
    const int c = lane & 7;
#pragma unroll
    for (int j = 0; j < 4; ++j) { const int n = (lane >> 3) + 8 * j; const LAS float* s = scr + (8 * c) * 33 + n;
        u32x4 o; o.x = cvtpk(s[0 * 33], s[1 * 33]); o.y = cvtpk(s[2 * 33], s[3 * 33]); o.z = cvtpk(s[4 * 33], s[5 * 33]); o.w = cvtpk(s[6 * 33], s[7 * 33]);
        *(u32x4*)(WT + (size_t)(n0 + n) * ldt + k0 + 8 * c) = o; }
    LDS_WAIT(); asm volatile("" ::: "memory");
}
__device__ __forceinline__ int in_srccol(int j) {
    if (j < 1024) { const int jj = j & 127; return (j & ~127) + (jj & 1) * 64 + (jj >> 1); }
    if (j < 6144) return j;
    return j + 8;
}
template <bool SILU>
__device__ __forceinline__ void gemv_item(const float* W, int ldw, int col0, const float* v0, const float* v1, const float* bias, float* out0, float* out1, int ostride, LAS float* red) {
    const int tid = threadIdx.x, w = tid >> 6, lane = tid & 63;
    float a0 = 0.f, a1 = 0.f; const float* wp = W + (size_t)(128 * w) * ldw + col0 + lane;
#pragma unroll 8
    for (int k = 0; k < 128; ++k) { float x0 = v0[128 * w + k], x1 = v1[128 * w + k]; if (SILU) { x0 = siluf_(x0); x1 = siluf_(x1); }
        const float wv = wp[(size_t)k * ldw]; a0 += x0 * wv; a1 += x1 * wv; }
    red[(w * 2 + 0) * 64 + lane] = a0; red[(w * 2 + 1) * 64 + lane] = a1;
    __syncthreads();
    if (w == 0) { float s0 = bias ? bias[col0 + lane] : 0.f, s1 = s0;
#pragma unroll
        for (int q = 0; q < 8; ++q) { s0 += red[(q * 2) * 64 + lane]; s1 += red[(q * 2 + 1) * 64 + lane]; }
        out0[(size_t)lane * ostride] = s0; out1[(size_t)lane * ostride] = s1; }
    __syncthreads();
}

struct Args { const float *x, *c, *ada_w, *ada_b, *norm1_w, *w_in, *b_f, *ret_proj, *fox_proj, *w_out, *norm2_w, *w_gate, *w_up, *w_down, *norm_f_w; float* out; unsigned char* ws; };

__global__ void __launch_bounds__(512) mega_fwd(Args a) {
    extern __shared__ __attribute__((aligned(16))) unsigned char lds_raw[];
    cg::grid_group grid = cg::this_grid();
    LAS unsigned char* lds = (LAS unsigned char*)lds_raw;
    const int tid = threadIdx.x, lane = tid & 63, wave = __builtin_amdgcn_readfirstlane(tid >> 6);
    const int G = gridDim.x, bx = blockIdx.x;
    const int vcu = (G % 8 == 0) ? (bx % 8) * (G / 8) + bx / 8 : bx;
    const int gw = vcu * 8 + wave, NGW = G * 8;
    unsigned char* ws = a.ws;
    float* MOD = (float*)(ws + WS_MOD); float* BIAS2 = (float*)(ws + WS_BIAS2); float* LOGF = (float*)(ws + WS_LOGF); float* GC = (float*)(ws + WS_G);
    bf16_t* WIN_T = (bf16_t*)(ws + WS_WIN); bf16_t* PROJ_T = (bf16_t*)(ws + WS_PROJ); bf16_t* WOUT_T = (bf16_t*)(ws + WS_WOUT); bf16_t* WDOWN_T = (bf16_t*)(ws + WS_WDOWN);
    float* SSQ = (float*)(ws + WS_SSQ); bf16_t* HB = (bf16_t*)(ws + WS_H); float* GS = (float*)(ws + WS_H); bf16_t* RQK = (bf16_t*)(ws + WS_RQK); bf16_t* RV = (bf16_t*)(ws + WS_RV);
    bf16_t* YB = (bf16_t*)(ws + WS_YB); bf16_t* FK = (bf16_t*)(ws + WS_FK); bf16_t* FV = (bf16_t*)(ws + WS_FV); bf16_t* GRF = (bf16_t*)a.out;
    bf16_t* MERGED = (bf16_t*)(ws + WS_H); bf16_t* A2 = (bf16_t*)(ws + WS_RQK); bf16_t* ACT = (bf16_t*)(ws + WS_RV); bf16_t* GU_T = (bf16_t*)(ws + WS_WIN);
    { volatile LAS unsigned* misc = (volatile LAS unsigned*)(lds + LDS_BYTES - 256); if (tid < 8) misc[tid] = 0u; }
    __syncthreads();
    XcdBarrier xbar = xcd_barrier_post((unsigned*)(ws + WS_BAR), (volatile LAS unsigned*)(lds + LDS_BYTES - 256));
    if (a.ws == nullptr) grid.sync();
#define GSYNC() xcd_barrier(xbar)

#ifndef NO_P0
    REPEAT(PROBE_A) {
        for (int it = bx; it < 96; it += G) gemv_item<true>(a.ada_w, 6144, it * 64, a.c, a.c + 1024, a.ada_b, MOD + it * 64, MOD + 6144 + it * 64, 1, (LAS float*)lds);
        __syncthreads();
        LAS float* scr = (LAS float*)(lds + wave * 16384);
        constexpr int I_IN = 16 * 256, I_P = 16 * 32, I_DN = 44 * 32, NITEMS = I_IN + 3 * I_P + I_DN;
        for (int it = gw; it < NITEMS; it += NGW) {
            int r = it;
            if (r < I_IN) { const int kb = r / 256, nb = r % 256; transpose_item(a.w_in + in_srccol(nb * 32 + (lane & 31)), DINW, kb * 64, WIN_T, 1024, nb * 32, scr, lane); continue; } r -= I_IN;
            if (r < I_P) { const int kb = r / 32, nb = r % 32; transpose_item(a.ret_proj + nb * 32 + (lane & 31), 1024, kb * 64, PROJ_T, 2048, nb * 32, scr, lane); continue; } r -= I_P;
            if (r < I_P) { const int kb = r / 32, nb = r % 32; transpose_item(a.fox_proj + nb * 32 + (lane & 31), 1024, kb * 64, PROJ_T + 1024, 2048, nb * 32, scr, lane); continue; } r -= I_P;
            if (r < I_P) { const int kb = r / 32, nb = r % 32; transpose_item(a.w_out + nb * 32 + (lane & 31), 1024, kb * 64, WOUT_T, 1024, nb * 32, scr, lane); continue; } r -= I_P;
            { const int kb = r / 32, nb = r % 32; transpose_item(a.w_down + nb * 32 + (lane & 31), 1024, kb * 64, WDOWN_T, DFF, nb * 32, scr, lane); }
        }
    }
#endif
    GSYNC();
#ifndef NO_P1
    REPEAT(PROBE_A) {
        for (int it = bx; it < 88; it += G) { const int s = it >= 44, cb = (it - 44 * s) * 64;
            gemv_item<false>(s ? a.w_up : a.w_gate, DFF, cb, MOD + 3072, MOD + 6144 + 3072, nullptr, BIAS2 + 2 * cb + s, BIAS2 + NGU + 2 * cb + s, 2, (LAS float*)lds); }
        int lane1 = lane; asm volatile("" : "+v"(lane1));
        float wff[16][8];
#pragma unroll
        for (int j = 0; j < 4; ++j)
#pragma unroll
            for (int q = 0; q < 4; ++q) { const float* p = a.w_in + (size_t)(4 * lane1 + 256 * j + q) * DINW + 6144; const f32x4 w0 = *(const f32x4*)p, w1 = *(const f32x4*)(p + 4);
                wff[4 * j + q][0] = w0[0]; wff[4 * j + q][1] = w0[1]; wff[4 * j + q][2] = w0[2]; wff[4 * j + q][3] = w0[3]; wff[4 * j + q][4] = w1[0]; wff[4 * j + q][5] = w1[1]; wff[4 * j + q][6] = w1[2]; wff[4 * j + q][7] = w1[3]; }
        const float bfl = a.b_f[lane1 & 7];
        f32x4 v[4], vn[4];
        if (gw < MTOK) { const f32x4* xr0 = (const f32x4*)(a.x + (size_t)gw * DM) + lane1;
#pragma unroll
            for (int j = 0; j < 4; ++j) v[j] = xr0[64 * j]; }
        for (int m = gw; m < MTOK; m += NGW) {
            const int b = m >> 13; const float* mod = MOD + b * 6144;
            if (m + NGW < MTOK) { const f32x4* xrn = (const f32x4*)(a.x + (size_t)(m + NGW) * DM) + lane1;
#pragma unroll
                for (int j = 0; j < 4; ++j) vn[j] = xrn[64 * j]; }
            float s = 0.f;
#pragma unroll
            for (int j = 0; j < 4; ++j) { s += (v[j][0] * v[j][0] + v[j][1] * v[j][1]) + (v[j][2] * v[j][2] + v[j][3] * v[j][3]); }
            const float rstd = 1.0f / sqrtf(wave_sum(s) * (1.0f / DM) + EPS);
            float p8[8] = {0.f, 0.f, 0.f, 0.f, 0.f, 0.f, 0.f, 0.f};
            unsigned long long* o8 = (unsigned long long*)(HB + (size_t)m * DM) + lane1;
#pragma unroll
            for (int j = 0; j < 4; ++j) { const int col = 4 * lane1 + 256 * j;
                const f32x4 nw = *(const f32x4*)(a.norm1_w + col), sh = *(const f32x4*)(mod + col), sc = *(const f32x4*)(mod + 1024 + col);
                const f32x4 hv = (v[j] * rstd * nw) * (sc + 1.0f) + sh;
                o8[64 * j] = (unsigned long long)cvtpk(hv[0], hv[1]) | ((unsigned long long)cvtpk(hv[2], hv[3]) << 32);
#pragma unroll
                for (int q = 0; q < 4; ++q)
#pragma unroll
                    for (int hh = 0; hh < 8; ++hh) p8[hh] += hv[q] * wff[4 * j + q][hh]; }
#pragma unroll
            for (int hh = 0; hh < 8; ++hh) p8[hh] = wave_sum(p8[hh]);
            float mine = p8[0];
#pragma unroll
            for (int hh = 1; hh < 8; ++hh) mine = (lane1 & 7) == hh ? p8[hh] : mine;
            if (lane1 < 8) { const float z = mine + bfl; LOGF[(size_t)m * 8 + lane1] = fminf(z, 0.f) - log1pf(__expf(-fabsf(z))); }
#pragma unroll
            for (int j = 0; j < 4; ++j) v[j] = vn[j];
        }
    }
#endif
    GSYNC();
#ifndef NO_P2
    REPEAT(PROBE_G) {
        if (bx < 16) {
            const int b = bx >> 3, hh = bx & 7; const int s0 = tid * 16; float vals[16]; double tot = 0.0;
#pragma unroll
            for (int i = 0; i < 16; ++i) { vals[i] = LOGF[((size_t)b * SEQ + s0 + i) * 8 + hh]; tot += (double)vals[i]; }
            double incl = tot;
#pragma unroll
            for (int o = 1; o < 64; o <<= 1) { const double t2 = __shfl_up(incl, o); if (lane >= o) incl += t2; }
            LAS double* wsum = (LAS double*)lds;
            if (lane == 63) wsum[wave] = incl;
            __syncthreads();
            double run = incl - tot;
            for (int q = 0; q < wave; ++q) run += wsum[q];
#pragma unroll
            for (int i = 0; i < 16; ++i) { run += (double)vals[i]; GC[(size_t)bx * SEQ + s0 + i] = (float)(run * 11.313708498984761); }
            __syncthreads();
        }
        pg8::Gemm g{HB, WIN_T, MTOK, NIN, DM}; pg8::StaticOrder S; S.init(MTOK, NIN, G, bx);
        EpiIn E{RQK, RV, YB, FK, FV, GRF};
        pg8::gemm_phase<EpiIn, pg8::StaticOrder>(lds, g, S, E);
    }
#endif
    GSYNC();
#ifndef NO_P3A
    REPEAT(PROBE_A) {
        LAS float* scr = (LAS float*)(lds + wave * 16384);
        for (int it = gw; it < 16 * 176; it += NGW) { const int kb = it / 176, nb = it % 176; const int np = nb * 32 + (lane & 31);
            transpose_item(((np & 1) ? a.w_up : a.w_gate) + (np >> 1), DFF, kb * 64, GU_T, 1024, nb * 32, scr, lane); }
        __syncthreads();
        for (int u = bx; u < 8 * 31; u += G) { const int bh = u / 31, g = u % 31; ret::unit<false>(bh, g, RQK, RV, YB, GS, lds); }
    }
#endif
    GSYNC();
    {
        const int gt = vcu * 512 + tid;
        if (gt < 8 * 16384) { const int bh = gt >> 14, pr = gt & 16383; const float lg = log2f(1.0f - exp2f(-5.0f - (float)(bh & 3))); const float dg = exp2f(64.f * ret::NCH * lg);
            f32x2* p = (f32x2*)(GS + (size_t)bh * ret::NGRP * 32768) + pr; f32x2 v[31];
#pragma unroll
            for (int q = 0; q < 31; ++q) v[q] = p[(size_t)q * 16384];
            f32x2 run = v[0];
#pragma unroll
            for (int q = 1; q < 31; ++q) { run = run * dg + v[q]; p[(size_t)q * 16384] = run; }
        }
    }
    GSYNC();
#ifndef NO_P3B
    {
#ifndef NO_RET2
        if (PROBE_R) { for (int u = bx; u < 256; u += G) ret::unit<true, true>(u >> 5, u & 31, RQK, RV, YB, GS, lds, (bf16_t*)(ws + 14 * MiB)); __syncthreads(); }
        for (int u = bx; u < 256; u += G) ret::unit<true>(u >> 5, u & 31, RQK, RV, YB, GS, lds);
        __syncthreads();
#endif
#ifndef NO_ATT
        char* alds = (char*)lds_raw;
        for (int dry = PROBE_T ? 1 : 0; dry >= 0; --dry) if (vcu < 256) {
            int L = vcu, pass = 0;
#define FOX_REF(R, L_, pass_) do { const int bh_ = (L_) >> 4, x_ = (L_) & 15, b_ = bh_ >> 3, h_ = bh_ & 7, qb_ = (pass_) ? x_ : 31 - x_;     \
                (R).K = FK + (size_t)b_ * SEQ * 1024 + h_ * 128; (R).V = FV + (size_t)b_ * SEQ * 1024 + h_ * 128; (R).G = GC + (size_t)bh_ * SEQ; \
                (R).Q = YB + ((size_t)b_ * SEQ + (size_t)qb_ * 256) * 2048 + 1024 + h_ * 128; (R).O = dry ? (bf16_t*)(ws + 14 * MiB) : const_cast<bf16_t*>((R).Q); (R).P0 = qb_ * 256; } while (0)
            fox::BlockRef cur; FOX_REF(cur, L, 0);
            fox::Seam S;
            fox::prime(cur, alds, S);
            for (;;) {
                const bool more_pass = pass == 0, more_item = L + G < 256, last = !more_pass && !more_item;
                int Ln = L, passn = pass + 1; if (!more_pass) { passn = 0; Ln = more_item ? L + G : L; }
                fox::BlockRef nxt = cur; if (!last) FOX_REF(nxt, Ln, passn);
                fox::block(cur, nxt, alds, S);
                if (last) break;
                cur = nxt; L = Ln; pass = passn;
            }
#undef FOX_REF
            asm volatile("s_waitcnt vmcnt(0)" ::: "memory");
            __syncthreads();
        }
#endif
    }
#endif
    GSYNC();
#ifndef NO_P4
    REPEAT(PROBE_F) {
        pg8::Gemm g{YB, PROJ_T, MTOK, DM, 2048}; pg8::StaticOrder S; S.init(MTOK, DM, G, bx);
        EpiMerge E{GRF, MERGED};
        pg8::gemm_phase<EpiMerge, pg8::StaticOrder>(lds, g, S, E);
    }
#endif
    GSYNC();
#ifndef NO_P5
    REPEAT(PROBE_F) {
        pg8::Gemm g{MERGED, WOUT_T, MTOK, DM, DM}; pg8::StaticOrder S; S.init(MTOK, DM, G, bx);
        EpiWout E{a.x, MOD, a.norm2_w, a.out, A2, SSQ};
        pg8::gemm_phase<EpiWout, pg8::StaticOrder>(lds, g, S, E);
    }
#endif
    GSYNC();
#ifndef NO_P6
    REPEAT(PROBE_F) {
        pg8::Gemm g{A2, GU_T, MTOK, NGU, DM}; pg8::StaticOrder S; S.init(MTOK, NGU, G, bx);
        EpiGU E{SSQ, BIAS2, ACT};
        pg8::gemm_phase<EpiGU, pg8::StaticOrder>(lds, g, S, E);
    }
#endif
    GSYNC();
#ifndef NO_P7
    {
        pg8::Gemm g{ACT, WDOWN_T, MTOK, DM, DFF}; pg8::StaticOrder S; S.init(MTOK, DM, G, bx);
        if (PROBE_D) { EpiDown E0{MOD, a.out, (float*)(ws + 32 * MiB)}; pg8::gemm_phase<EpiDown, pg8::StaticOrder>(lds, g, S, E0); }
        EpiDown E{MOD, a.out, a.out};
        pg8::gemm_phase<EpiDown, pg8::StaticOrder>(lds, g, S, E);
    }
#endif
    GSYNC();
#ifndef NO_P8
    {
        int lane8 = lane; asm volatile("" : "+v"(lane8));
        for (int m0 = gw; m0 < MTOK; m0 += 4 * NGW) {
            f32x4 v[4][4];
#pragma unroll
            for (int i = 0; i < 4; ++i) { const int m = m0 + i * NGW; if (m < MTOK) { const f32x4* xr = (const f32x4*)(a.out + (size_t)m * DM) + lane8;
#pragma unroll
                for (int j = 0; j < 4; ++j) v[i][j] = xr[64 * j]; } }
#pragma unroll
            for (int i = 0; i < 4; ++i) { const int m = m0 + i * NGW; if (m < MTOK) { f32x4* xr = (f32x4*)(a.out + (size_t)m * DM) + lane8; float s = 0.f;
#pragma unroll
                for (int j = 0; j < 4; ++j) s += (v[i][j][0] * v[i][j][0] + v[i][j][1] * v[i][j][1]) + (v[i][j][2] * v[i][j][2] + v[i][j][3] * v[i][j][3]);
                const float rstd = 1.0f / sqrtf(wave_sum(s) * (1.0f / DM) + EPS);
#pragma unroll
                for (int j = 0; j < 4; ++j) { const f32x4 nw = *(const f32x4*)(a.norm_f_w + 4 * lane8 + 256 * j); xr[64 * j] = v[i][j] * rstd * nw; } } }
        }
    }
#endif
    if (PROBE_S) { for (int q = 0; q < 9; ++q) GSYNC(); }
}

extern "C" void kernel_launch(void* const* d_in, const int* in_sizes, int n_in, void* d_out, int out_size, void* d_ws, size_t ws_size, hipStream_t stream) {
    static int grid = 0;
    if (grid == 0) {
        if (n_in != 15 || out_size != MTOK * DM || ws_size < WS_END) { fprintf(stderr, "kernel_launch: unexpected shapes (n_in %d out %d ws %zu)\n", n_in, out_size, ws_size); grid = -1; return; }
        int dev = 0, cus = 0, per_cu = 0;
        (void)hipGetDevice(&dev); (void)hipDeviceGetAttribute(&cus, hipDeviceAttributeMultiprocessorCount, dev);
        (void)hipFuncSetAttribute((const void*)mega_fwd, hipFuncAttributeMaxDynamicSharedMemorySize, LDS_BYTES);
        if (hipOccupancyMaxActiveBlocksPerMultiprocessor(&per_cu, (const void*)mega_fwd, 512, LDS_BYTES) != hipSuccess || per_cu < 1) { fprintf(stderr, "kernel_launch: occupancy query failed\n"); per_cu = 1; }
        (void)hipGetLastError();
        if (per_cu > 1) per_cu = 1;
        grid = cus * per_cu;
    }
    if (grid < 0) return;
    (void)hipMemsetAsync((char*)d_ws + WS_BAR, 0, 16384, stream);
    Args a{};
    a.x = (const float*)d_in[0]; a.c = (const float*)d_in[1]; a.ada_w = (const float*)d_in[2]; a.ada_b = (const float*)d_in[3]; a.norm1_w = (const float*)d_in[4];
    a.w_in = (const float*)d_in[5]; a.b_f = (const float*)d_in[6]; a.ret_proj = (const float*)d_in[7]; a.fox_proj = (const float*)d_in[8]; a.w_out = (const float*)d_in[9];
    a.norm2_w = (const float*)d_in[10]; a.w_gate = (const float*)d_in[11]; a.w_up = (const float*)d_in[12]; a.w_down = (const float*)d_in[13]; a.norm_f_w = (const float*)d_in[14];
    a.out = (float*)d_out; a.ws = (unsigned char*)d_ws;
    void* args[] = {&a};
    hipError_t e = hipLaunchCooperativeKernel((const void*)mega_fwd, dim3(grid), dim3(512), args, LDS_BYTES, stream);
    if (e != hipSuccess) fprintf(stderr, "kernel_launch: cooperative launch failed: %s (grid %d)\n", hipGetErrorString(e), grid);
}
```
